# Optimizing an MI355X kernel written in HIP

```python
import math
import jax, jax.numpy as jnp
from jax import lax
import numpy as np

D_MODEL = 1024
BATCH = 8
SEQ = 2048
DEPTH = 2

D_MIX = 2 * D_MODEL
EPS = 1e-6
MLSTM_HEADS = 4
MLSTM_DV = D_MIX // 2
MLSTM_DV_HEAD = MLSTM_DV // MLSTM_HEADS
MLSTM_DK_HEAD = MLSTM_DV_HEAD // 2
MLSTM_DK = MLSTM_HEADS * MLSTM_DK_HEAD
MLSTM_CHUNK = 64
CONV_WIDTH = 4
S5_WIDTH = D_MIX // 2
S5_GROUP = 16
S5_GROUPS = S5_WIDTH // S5_GROUP
S5_STATE = 64
S5_DT_MIN = 1e-3
S5_DT_MAX = 1e-1
GLA_HEADS = 4
GLA_DV = D_MIX
GLA_DK = D_MIX // 2
GLA_DV_HEAD = GLA_DV // GLA_HEADS
GLA_DK_HEAD = GLA_DK // GLA_HEADS
GLA_GATE_RANK = 16
GLA_TAU = 16.0
GLA_CHUNK = 64
EVEN_SIZES = (MLSTM_DK, MLSTM_DK, MLSTM_DV, MLSTM_DV, MLSTM_HEADS, MLSTM_HEADS, S5_WIDTH, D_MIX)
EVEN_IN = sum(EVEN_SIZES)
ODD_SIZES = (GLA_DK, GLA_DK, GLA_DV, D_MIX, GLA_GATE_RANK)
ODD_IN = sum(ODD_SIZES)
N_EVEN = (DEPTH + 1) // 2
N_ODD = DEPTH // 2

kernel_name = "hybrid_mlstm_s5_gla_trunk"


def _split(t, sizes):
    idx = [int(v) for v in np.cumsum(sizes)[:-1]]
    return jnp.split(t, idx, axis=-1)


def rmsnorm(x, g):
    xf = x.astype(jnp.float32)
    y = xf * lax.rsqrt(jnp.mean(xf * xf, axis=-1, keepdims=True) + EPS)
    return (y * g.astype(jnp.float32)).astype(x.dtype)


def headwise_rmsnorm(h, g, n_heads):
    b, s, w = h.shape
    hf = h.astype(jnp.float32).reshape(b, s, n_heads, w // n_heads)
    hf = hf * lax.rsqrt(jnp.mean(hf * hf, axis=-1, keepdims=True) + EPS)
    return hf.reshape(b, s, w) * g.astype(jnp.float32)


def causal_dwconv(x, w, bias):
    c = x.shape[-1]
    y = lax.conv_general_dilated(
        x.astype(jnp.float32), w.astype(jnp.float32)[:, None, :],
        window_strides=(1,), padding=[(CONV_WIDTH - 1, 0)],
        dimension_numbers=('NWC', 'WIO', 'NWC'), feature_group_count=c)
    return y + bias.astype(jnp.float32)


def mlstm_chunkwise(q, k, v, i_pre, f_pre):
    b_, s_, h_, dk = q.shape
    dv = v.shape[-1]
    L = MLSTM_CHUNK
    nc = s_ // L
    q = q * (dk ** -0.5)
    logf = jax.nn.log_sigmoid(f_pre)
    qc = q.reshape(b_, nc, L, h_, dk)
    kc = k.reshape(b_, nc, L, h_, dk)
    vc = v.reshape(b_, nc, L, h_, dv)
    ic = i_pre.reshape(b_, nc, L, h_)
    bcum = jnp.cumsum(logf.reshape(b_, nc, L, h_), axis=2)
    g = bcum[:, :, -1]
    causal = jnp.tril(jnp.ones((L, L), dtype=bool))
    dmat = bcum[:, :, :, None, :] - bcum[:, :, None, :, :] + ic[:, :, None, :, :]
    dmat = jnp.where(causal[None, None, :, :, None], dmat, -jnp.inf)
    a = g[:, :, None, :] - bcum + ic
    m_loc = jnp.max(a, axis=2)
    w_loc = jnp.exp(a - m_loc[:, :, None, :])
    c_loc = jnp.einsum('bclh,bclhk,bclhv->bchkv', w_loc, kc, vc)
    n_loc = jnp.einsum('bclh,bclhk->bchk', w_loc, kc)

    def step(carry, inp):
        c_st, n_st, m_st = carry
        g_c, m_l, c_l, n_l = inp
        m_new = jnp.maximum(g_c + m_st, m_l)
        s_prev = jnp.exp(g_c + m_st - m_new)
        s_loc = jnp.exp(m_l - m_new)
        c_new = s_prev[..., None, None] * c_st + s_loc[..., None, None] * c_l
        n_new = s_prev[..., None] * n_st + s_loc[..., None] * n_l
        return (c_new, n_new, m_new), (c_st, n_st, m_st)

    init = (jnp.zeros((b_, h_, dk, dv), jnp.float32),
            jnp.zeros((b_, h_, dk), jnp.float32),
            jnp.zeros((b_, h_), jnp.float32))
    xs = (jnp.moveaxis(g, 1, 0), jnp.moveaxis(m_loc, 1, 0),
          jnp.moveaxis(c_loc, 1, 0), jnp.moveaxis(n_loc, 1, 0))
    _, (c_prev, n_prev, m_prev) = lax.scan(step, init, xs)
    c_prev = jnp.moveaxis(c_prev, 0, 1)
    n_prev = jnp.moveaxis(n_prev, 0, 1)
    m_prev = jnp.moveaxis(m_prev, 0, 1)
    inter_log = bcum + m_prev[:, :, None, :]
    m_t = jnp.maximum(inter_log, jnp.max(dmat, axis=3))
    w_intra = jnp.exp(dmat - m_t[:, :, :, None, :])
    w_inter = jnp.exp(inter_log - m_t)
    sc = w_intra * jnp.einsum('bcthk,bcshk->bctsh', qc, kc)
    num = (jnp.einsum('bctsh,bcshv->bcthv', sc, vc)
           + w_inter[..., None] * jnp.einsum('bcthk,bchkv->bcthv', qc, c_prev))
    den = jnp.sum(sc, axis=3) + w_inter * jnp.einsum('bcthk,bchk->bcth', qc, n_prev)
    h = num / jnp.maximum(jnp.abs(den), jnp.exp(-m_t))[..., None]
    return h.reshape(b_, s_, h_, dv)


def s5_branch(u, lam_re, lam_im, log_dt, b_re, b_im, c_re, c_im, d_skip, glu_w, glu_b):
    f32 = jnp.float32
    b_, s_, _ = u.shape
    uf = u.astype(f32)
    lam = lax.complex(lam_re.astype(f32), lam_im.astype(f32))
    dt = jnp.exp(log_dt.astype(f32))[:, None]
    a_bar = jnp.exp(lam * dt)
    b_bar = lax.complex(b_re.astype(f32), b_im.astype(f32)) * ((a_bar - 1.0) / lam)[..., None]
    ug = uf.reshape(b_, s_, S5_GROUPS, S5_GROUP)
    bu = jnp.einsum('bsgc,gpc->bsgp', ug, b_bar)
    a_seq = jnp.broadcast_to(a_bar, (1, s_, S5_GROUPS, S5_STATE))

    def combine(e1, e2):
        a1, x1 = e1
        a2, x2 = e2
        return a2 * a1, a2 * x1 + x2

    _, states = lax.associative_scan(combine, (a_seq, bu), axis=1)
    y = (jnp.einsum('bsgp,gcp->bsgc', jnp.real(states), c_re.astype(f32))
         - jnp.einsum('bsgp,gcp->bsgc', jnp.imag(states), c_im.astype(f32)))
    y = y.reshape(b_, s_, S5_WIDTH) + d_skip.astype(f32) * uf
    y = jax.nn.gelu(y)
    return y * jax.nn.sigmoid(y @ glu_w.astype(f32) + glu_b.astype(f32))


def gla_chunkwise(q, k, v, log_alpha):
    b_, s_, h_, dk = q.shape
    dv = v.shape[-1]
    L = GLA_CHUNK
    nc = s_ // L
    q = q * (dk ** -0.5)
    qc = q.reshape(b_, nc, L, h_, dk)
    kc = k.reshape(b_, nc, L, h_, dk)
    vc = v.reshape(b_, nc, L, h_, dv)
    bcum = jnp.cumsum(log_alpha.reshape(b_, nc, L, h_, dk), axis=2)
    g = bcum[:, :, -1]
    q_t = qc * jnp.exp(bcum)
    k_t = kc * jnp.exp(-bcum)
    causal = jnp.tril(jnp.ones((L, L), dtype=bool))
    attn = jnp.einsum('bcthk,bcshk->bchts', q_t, k_t)
    attn = jnp.where(causal[None, None, None], attn, 0.0)
    o_intra = jnp.einsum('bchts,bcshv->bcthv', attn, vc)
    k_end = kc * jnp.exp(g[:, :, None] - bcum)
    upd = jnp.einsum('bcshk,bcshv->bchkv', k_end, vc)

    def step(st, inp):
        g_c, u_c = inp
        return jnp.exp(g_c)[..., None] * st + u_c, st

    _, s_prev = lax.scan(step, jnp.zeros((b_, h_, dk, dv), jnp.float32),
                         (jnp.moveaxis(g, 1, 0), jnp.moveaxis(upd, 1, 0)))
    s_prev = jnp.moveaxis(s_prev, 0, 1)
    o_inter = jnp.einsum('bcthk,bchkv->bcthv', q_t, s_prev)
    return (o_intra + o_inter).reshape(b_, s_, h_, dv)


def even_layer(h, w_in, conv_w, conv_b, i_bias, f_bias, head_g,
               lam_re, lam_im, log_dt, b_re, b_im, c_re, c_im, d_skip, glu_w, glu_b, w_out):
    f32 = jnp.float32
    b_, s_, _ = h.shape
    proj = h @ w_in
    q, k, v, o, i_pre, f_pre, u, z = _split(proj, EVEN_SIZES)
    qk = jax.nn.silu(causal_dwconv(jnp.concatenate([q, k], axis=-1), conv_w, conv_b))
    q, k = qk[..., :MLSTM_DK], qk[..., MLSTM_DK:]
    hd = lambda t, dh: t.astype(f32).reshape(b_, s_, MLSTM_HEADS, dh)
    h_a = mlstm_chunkwise(hd(q, MLSTM_DK_HEAD), hd(k, MLSTM_DK_HEAD), hd(v, MLSTM_DV_HEAD),
                          i_pre.astype(f32) + i_bias.astype(f32),
                          f_pre.astype(f32) + f_bias.astype(f32))
    h_a = jax.nn.sigmoid(o.astype(f32)) * h_a.reshape(b_, s_, MLSTM_DV)
    h_a = headwise_rmsnorm(h_a, head_g, MLSTM_HEADS)
    h_b = s5_branch(u, lam_re, lam_im, log_dt, b_re, b_im, c_re, c_im, d_skip, glu_w, glu_b)
    y = jnp.concatenate([h_a, h_b], axis=-1) * jax.nn.silu(z.astype(f32))
    return y.astype(h.dtype) @ w_out


def odd_layer(h, w_in, w_alpha, b_alpha, head_g, w_out):
    f32 = jnp.float32
    b_, s_, _ = h.shape
    proj = h @ w_in
    q, k, v, z, r = _split(proj, ODD_SIZES)
    log_alpha = jax.nn.log_sigmoid(r.astype(f32) @ w_alpha.astype(f32)
                                   + b_alpha.astype(f32)) / GLA_TAU
    hd = lambda t, dh: t.astype(f32).reshape(b_, s_, GLA_HEADS, dh)
    o_c = gla_chunkwise(hd(q, GLA_DK_HEAD), hd(k, GLA_DK_HEAD), hd(v, GLA_DV_HEAD),
                        hd(log_alpha, GLA_DK_HEAD))
    o_c = headwise_rmsnorm(o_c.reshape(b_, s_, GLA_DV), head_g, GLA_HEADS)
    y = o_c * jax.nn.silu(z.astype(f32))
    return y.astype(h.dtype) @ w_out


def setup_inputs(seed: int = 0) -> dict:
    key = jax.random.key(seed)
    ks = jax.random.split(key, 26)
    f32 = jnp.float32

    def nrm(k, shape, scale):
        return scale * jax.random.normal(k, shape, f32)

    ne, no = N_EVEN, N_ODD
    gp = (ne, S5_GROUPS, S5_STATE)
    n_idx = jnp.arange(S5_STATE, dtype=f32)
    return {
        "x": nrm(ks[0], (BATCH, SEQ, D_MODEL), 1.0),
        "norm_g": 1.0 + nrm(ks[1], (DEPTH, D_MODEL), 0.01),
        "final_norm_g": 1.0 + nrm(ks[2], (D_MODEL,), 0.01),
        "ev_w_in": nrm(ks[3], (ne, D_MODEL, EVEN_IN), D_MODEL ** -0.5),
        "ev_conv_w": nrm(ks[4], (ne, CONV_WIDTH, 2 * MLSTM_DK), CONV_WIDTH ** -0.5),
        "ev_conv_b": nrm(ks[5], (ne, 2 * MLSTM_DK), 0.01),
        "ev_i_bias": nrm(ks[6], (ne, MLSTM_HEADS), 0.1),
        "ev_f_bias": jnp.linspace(3.0, 6.0, MLSTM_HEADS, dtype=f32) + nrm(ks[7], (ne, MLSTM_HEADS), 0.1),
        "ev_head_g": 1.0 + nrm(ks[8], (ne, MLSTM_DV), 0.01),
        "s5_lam_re": -0.5 + nrm(ks[9], gp, 0.01),
        "s5_lam_im": jnp.pi * n_idx + nrm(ks[10], gp, 0.01),
        "s5_log_dt": jax.random.uniform(ks[11], (ne, S5_GROUPS), f32,
                                        math.log(S5_DT_MIN), math.log(S5_DT_MAX)),
        "s5_b_re": nrm(ks[12], (ne, S5_GROUPS, S5_STATE, S5_GROUP), (2 * S5_GROUP) ** -0.5),
        "s5_b_im": nrm(ks[13], (ne, S5_GROUPS, S5_STATE, S5_GROUP), (2 * S5_GROUP) ** -0.5),
        "s5_c_re": nrm(ks[14], (ne, S5_GROUPS, S5_GROUP, S5_STATE), (2 * S5_STATE) ** -0.5),
        "s5_c_im": nrm(ks[15], (ne, S5_GROUPS, S5_GROUP, S5_STATE), (2 * S5_STATE) ** -0.5),
        "s5_d": nrm(ks[16], (ne, S5_WIDTH), 0.5),
        "s5_glu_w": nrm(ks[17], (ne, S5_WIDTH, S5_WIDTH), S5_WIDTH ** -0.5),
        "s5_glu_b": nrm(ks[18], (ne, S5_WIDTH), 0.01),
        "ev_w_out": nrm(ks[19], (ne, D_MIX, D_MODEL), D_MIX ** -0.5),
        "od_w_in": nrm(ks[20], (no, D_MODEL, ODD_IN), D_MODEL ** -0.5),
        "gla_w_alpha": nrm(ks[21], (no, GLA_GATE_RANK, GLA_DK), GLA_GATE_RANK ** -0.5),
        "gla_b_alpha": nrm(ks[22], (no, GLA_DK), 0.1),
        "gla_head_g": 1.0 + nrm(ks[23], (no, GLA_DV), 0.01),
        "od_w_out": nrm(ks[24], (no, D_MIX, D_MODEL), D_MIX ** -0.5),
    }


def reference(x, norm_g, final_norm_g, ev_w_in, ev_conv_w, ev_conv_b, ev_i_bias, ev_f_bias,
              ev_head_g, s5_lam_re, s5_lam_im, s5_log_dt, s5_b_re, s5_b_im, s5_c_re, s5_c_im,
              s5_d, s5_glu_w, s5_glu_b, ev_w_out, od_w_in, gla_w_alpha, gla_b_alpha,
              gla_head_g, od_w_out):
    for layer in range(DEPTH):
        hn = rmsnorm(x, norm_g[layer])
        j = layer // 2
        if layer % 2 == 0:
            y = even_layer(hn, ev_w_in[j], ev_conv_w[j], ev_conv_b[j], ev_i_bias[j], ev_f_bias[j],
                           ev_head_g[j], s5_lam_re[j], s5_lam_im[j], s5_log_dt[j], s5_b_re[j],
                           s5_b_im[j], s5_c_re[j], s5_c_im[j], s5_d[j], s5_glu_w[j], s5_glu_b[j],
                           ev_w_out[j])
        else:
            y = odd_layer(hn, od_w_in[j], gla_w_alpha[j], gla_b_alpha[j], gla_head_g[j], od_w_out[j])
        x = x + y.astype(x.dtype)
    return rmsnorm(x, final_norm_g)
```

```cpp
#include <hip/hip_runtime.h>
#include <stdint.h>

typedef unsigned short bf16_t;
constexpr int BATCH = 8, SEQ = 2048, DM = 1024, M_ = BATCH * SEQ;
constexpr int NP = 6144;
constexpr float EPS = 1e-6f;

constexpr size_t MiB = 1u << 20;
constexpr size_t WS_WIN = 1 * MiB;
constexpr size_t WS_WGLU = 13 * MiB;
constexpr size_t WS_WOUT0 = 15 * MiB;
constexpr size_t WS_WOUT1 = 19 * MiB;
constexpr size_t WS_HN = 23 * MiB;
constexpr size_t WS_P = 55 * MiB;
constexpr size_t WS_GIF = 247 * MiB;
constexpr size_t WS_R = 248 * MiB;
constexpr size_t WS_RSQ0 = 249 * MiB;
constexpr size_t WS_RSQ1 = 249 * MiB + 65536;

__device__ __forceinline__ float bf2f(bf16_t v) { return __uint_as_float(((unsigned)v) << 16); }
__device__ __forceinline__ bf16_t f2bf(float f) { unsigned u = __float_as_uint(f); u += 0x7fffu + ((u >> 16) & 1u); return (bf16_t)(u >> 16); }
__device__ __forceinline__ float sigmoidf_(float x) { return 1.f / (1.f + __expf(-x)); }
__device__ __forceinline__ float siluf_(float x) { return x * sigmoidf_(x); }
__device__ __forceinline__ float logsigmoidf_(float x) { return fminf(x, 0.f) - log1pf(expf(-fabsf(x))); }
__device__ __forceinline__ float gelu_tanh(float x) { const float c = 0.7978845608028654f; float u = c * (x + 0.044715f * x * x * x); return 0.5f * x * (1.f + tanhf(u)); }
__device__ __forceinline__ float wave_sum(float v) {
#pragma unroll
    for (int o = 1; o < 64; o <<= 1) v += __shfl_xor(v, o);
    return v;
}

__device__ __forceinline__ int colmap0(int n) {
    if (n < 2048) return n;
    if (n < 3072) return 3080 + (n - 2048);
    if (n < 4096) return 2048 + (n - 3072);
    if (n < 5120) return 5128 + (n - 4096);
    return 4104 + (n - 5120);
}
__global__ __launch_bounds__(256) void k_convT(const float* W, int ldw, int K, int N, const float* scale, int mode, bf16_t* out) {
    __shared__ float t[32][33];
    const int n0 = blockIdx.x * 32, k0 = blockIdx.y * 32;
    const int tx = threadIdx.x & 31, ty = threadIdx.x >> 5;
    for (int i = ty; i < 32; i += 8) {
        const int n = n0 + tx, k = k0 + i;
        const int c = mode ? colmap0(n) : n;
        float w = W[(size_t)k * ldw + c];
        if (scale) w *= scale[k];
        t[i][tx] = w;
    }
    __syncthreads();
    for (int i = ty; i < 32; i += 8) out[(size_t)(n0 + i) * K + k0 + tx] = f2bf(t[tx][i]);
}

template <int NC>
__global__ __launch_bounds__(256) void k_rows(const float* X, const float* g, const float* W, int ldw, int col0, const float* bias_a, const float* bias_b,
                                              bf16_t* HN, float* rowsq, float* G) {
    const int lane = threadIdx.x & 63, wv = threadIdx.x >> 6;
    const int row = blockIdx.x * 4 + wv;
    const float* xr = X + (size_t)row * DM;
    float x[16];
#pragma unroll
    for (int j = 0; j < 4; ++j) { const float4 v = *(const float4*)(xr + j * 256 + lane * 4); x[j * 4 + 0] = v.x; x[j * 4 + 1] = v.y; x[j * 4 + 2] = v.z; x[j * 4 + 3] = v.w; }
    float ss = 0.f;
#pragma unroll
    for (int i = 0; i < 16; ++i) ss += x[i] * x[i];
    ss = wave_sum(ss);
    const float inv = rsqrtf(ss * (1.f / DM) + EPS);
    if (lane == 0) rowsq[row] = ss;
#pragma unroll
    for (int j = 0; j < 4; ++j) {
        ushort4 o; o.x = f2bf(x[j * 4 + 0]); o.y = f2bf(x[j * 4 + 1]); o.z = f2bf(x[j * 4 + 2]); o.w = f2bf(x[j * 4 + 3]);
        *(ushort4*)(HN + (size_t)row * DM + j * 256 + lane * 4) = o;
    }
    float d[NC];
#pragma unroll
    for (int c = 0; c < NC; ++c) d[c] = 0.f;
#pragma unroll
    for (int j = 0; j < 4; ++j)
#pragma unroll
        for (int e = 0; e < 4; ++e) {
            const int k = j * 256 + lane * 4 + e;
            const float xv = x[j * 4 + e] * g[k];
            const float* wr = W + (size_t)k * ldw + col0;
#pragma unroll
            for (int c = 0; c < NC; ++c) d[c] += xv * wr[c];
        }
#pragma unroll
    for (int c = 0; c < NC; ++c) {
        float s = wave_sum(d[c]) * inv;
        if (bias_a) s += (c < NC / 2) ? bias_a[c] : bias_b[c - NC / 2];
        if (lane == 0) G[(size_t)row * NC + c] = s;
    }
}

struct EpiProj { bf16_t* P; const float* rowsq; __device__ void operator()(int r, int c, float a) const { P[(size_t)r * NP + c] = f2bf(a * rsqrtf(rowsq[r] * (1.f / DM) + EPS)); } };
struct EpiGlu { bf16_t* P; const float* b; __device__ void operator()(int r, int c, float a) const {
    bf16_t* p = P + (size_t)r * NP; const float yg = bf2f(p[2048 + c]), zb = bf2f(p[4096 + c]);
    p[4096 + c] = f2bf(yg * sigmoidf_(a + b[c]) * siluf_(zb)); } };
struct EpiRes { const float* X; float* O; __device__ void operator()(int r, int c, float a) const { O[(size_t)r * DM + c] = X[(size_t)r * DM + c] + a; } };

template <class Epi>
__global__ __launch_bounds__(256) void k_gemm(const bf16_t* A, int lda, const bf16_t* Bt, int ldb, int K, Epi E) {
    __shared__ float sA[16][68], sB[16][68];
    const int tx = threadIdx.x & 15, ty = threadIdx.x >> 4;
    const int m0 = blockIdx.y * 64, n0 = blockIdx.x * 64;
    float acc[4][4];
#pragma unroll
    for (int i = 0; i < 4; ++i)
#pragma unroll
        for (int j = 0; j < 4; ++j) acc[i][j] = 0.f;
    for (int k0 = 0; k0 < K; k0 += 16) {
        for (int i = threadIdx.x; i < 1024; i += 256) {
            const int r = i >> 4, c = i & 15;
            sA[c][r] = bf2f(A[(size_t)(m0 + r) * lda + k0 + c]);
            sB[c][r] = bf2f(Bt[(size_t)(n0 + r) * ldb + k0 + c]);
        }
        __syncthreads();
#pragma unroll
        for (int k = 0; k < 16; ++k) {
            float a[4], b[4];
#pragma unroll
            for (int i = 0; i < 4; ++i) { a[i] = sA[k][ty * 4 + i]; b[i] = sB[k][tx * 4 + i]; }
#pragma unroll
            for (int i = 0; i < 4; ++i)
#pragma unroll
                for (int j = 0; j < 4; ++j) acc[i][j] += a[i] * b[j];
        }
        __syncthreads();
    }
#pragma unroll
    for (int i = 0; i < 4; ++i)
#pragma unroll
        for (int j = 0; j < 4; ++j) E(m0 + ty * 4 + i, n0 + tx * 4 + j, acc[i][j]);
}

__global__ __launch_bounds__(1024) void k_mlstm_naive(bf16_t* P, const float* gif, const float* conv_w, const float* conv_b) {
    const int b = blockIdx.x >> 2, h = blockIdx.x & 3;
    const int tid = threadIdx.x, v = tid & 255, kq = tid >> 8;
    __shared__ float sq[128], sk[128], sred[4][256], sden[2];
    float C[32];
#pragma unroll
    for (int j = 0; j < 32; ++j) C[j] = 0.f;
    float nst = 0.f, m = -1e30f;
    int ch = 0; float w0 = 0, w1 = 0, w2 = 0, w3 = 0, cb = 0, r0 = 0, r1 = 0, r2 = 0;
    if (tid < 256) {
        ch = (tid < 128) ? (h * 128 + tid) : (512 + h * 128 + (tid - 128));
        w0 = conv_w[0 * 1024 + ch]; w1 = conv_w[1 * 1024 + ch]; w2 = conv_w[2 * 1024 + ch]; w3 = conv_w[3 * 1024 + ch]; cb = conv_b[ch];
    }
    const float qscale = 0.08838834764831845f;
    for (int t = 0; t < SEQ; ++t) {
        const size_t row = (size_t)b * SEQ + t;
        bf16_t* pr = P + row * NP;
        if (tid < 256) {
            const float raw = bf2f(pr[ch]);
            const float cv = w0 * r0 + w1 * r1 + w2 * r2 + w3 * raw + cb;
            r0 = r1; r1 = r2; r2 = raw;
            const float val = siluf_(cv);
            if (tid < 128) sq[tid] = val * qscale; else sk[tid - 128] = val;
        }
        const float ip = gif[row * 8 + h], fp = gif[row * 8 + 4 + h];
        const float logf = logsigmoidf_(fp);
        const float mn = fmaxf(logf + m, ip);
        const float fs = expf(logf + m - mn), is = expf(ip - mn);
        m = mn;
        const float vv = bf2f(pr[1024 + h * 256 + v]);
        __syncthreads();
        float part = 0.f;
#pragma unroll
        for (int j = 0; j < 32; ++j) { const int k = kq * 32 + j; C[j] = fs * C[j] + is * sk[k] * vv; part += C[j] * sq[k]; }
        sred[kq][v] = part;
        if (tid < 128) {
            nst = fs * nst + is * sk[tid];
            const float dp = wave_sum(nst * sq[tid]);
            if ((tid & 63) == 0) sden[tid >> 6] = dp;
        }
        __syncthreads();
        if (tid < 256) {
            const float num = sred[0][v] + sred[1][v] + sred[2][v] + sred[3][v];
            const float den = sden[0] + sden[1];
            pr[1024 + h * 256 + v] = f2bf(num / fmaxf(fabsf(den), expf(-m)));
        }
    }
}

__global__ __launch_bounds__(256) void k_headnorm0(bf16_t* P, const float* head_g) {
    const int lane = threadIdx.x & 63, wv = threadIdx.x >> 6;
    const int item = blockIdx.x * 4 + wv;
    const int row = item >> 2, h = item & 3;
    bf16_t* pr = P + (size_t)row * NP;
    float val[4]; float ss = 0.f;
#pragma unroll
    for (int e = 0; e < 4; ++e) { const int c = h * 256 + lane * 4 + e; val[e] = sigmoidf_(bf2f(pr[3072 + c])) * bf2f(pr[1024 + c]); ss += val[e] * val[e]; }
    ss = wave_sum(ss);
    const float inv = rsqrtf(ss * (1.f / 256.f) + EPS);
#pragma unroll
    for (int e = 0; e < 4; ++e) { const int c = h * 256 + lane * 4 + e; pr[3072 + c] = f2bf(val[e] * inv * head_g[c] * siluf_(bf2f(pr[5120 + c]))); }
}

__global__ __launch_bounds__(64) void k_s5_naive(bf16_t* P, const float* lam_re, const float* lam_im, const float* log_dt, const float* b_re, const float* b_im,
                                                 const float* c_re, const float* c_im, const float* dskip) {
    const int b = blockIdx.x >> 6, g = blockIdx.x & 63, p = threadIdx.x;
    const float lr = lam_re[g * 64 + p], li = lam_im[g * 64 + p], dt = expf(log_dt[g]);
    const float ex = expf(lr * dt), cs = cosf(li * dt), sn = sinf(li * dt);
    const float ar = ex * cs, ai = ex * sn;
    const float s2 = sinf(0.5f * li * dt);
    const float a1r = expm1f(lr * dt) * cs - 2.f * s2 * s2, a1i = ai;
    const float den = lr * lr + li * li;
    const float qr = (a1r * lr + a1i * li) / den, qi = (a1i * lr - a1r * li) / den;
    float bbr[16], bbi[16], cr[16], ci[16];
#pragma unroll
    for (int c = 0; c < 16; ++c) {
        const float br = b_re[(size_t)(g * 64 + p) * 16 + c], bi = b_im[(size_t)(g * 64 + p) * 16 + c];
        bbr[c] = br * qr - bi * qi; bbi[c] = br * qi + bi * qr;
        cr[c] = c_re[(size_t)(g * 16 + c) * 64 + p]; ci[c] = c_im[(size_t)(g * 16 + c) * 64 + p];
    }
    const float dd = dskip[g * 16 + (p & 15)];
    float xr = 0.f, xi = 0.f;
    for (int t = 0; t < SEQ; ++t) {
        bf16_t* pu = P + ((size_t)b * SEQ + t) * NP + 2048 + g * 16;
        float u[16];
#pragma unroll
        for (int c = 0; c < 16; ++c) u[c] = bf2f(pu[c]);
        const float up = bf2f(pu[p & 15]);
        float bur = 0.f, bui = 0.f;
#pragma unroll
        for (int c = 0; c < 16; ++c) { bur += bbr[c] * u[c]; bui += bbi[c] * u[c]; }
        const float nxr = ar * xr - ai * xi + bur, nxi = ar * xi + ai * xr + bui;
        xr = nxr; xi = nxi;
        float my = 0.f;
#pragma unroll
        for (int c = 0; c < 16; ++c) { const float yc = wave_sum(cr[c] * xr - ci[c] * xi); my = (p == c) ? yc : my; }
        if (p < 16) pu[p] = f2bf(gelu_tanh(my + dd * up));
    }
}

__global__ __launch_bounds__(512) void k_gla_naive(bf16_t* P, const float* R, const float* w_alpha, const float* b_alpha) {
    const int blk = blockIdx.x, b = blk >> 3, h = (blk >> 1) & 3, half = blk & 1;
    const int tid = threadIdx.x, v = tid & 255, kh = tid >> 8;
    __shared__ float sq[256], sk[256], sa[256], sred[2][256];
    float S[128];
#pragma unroll
    for (int j = 0; j < 128; ++j) S[j] = 0.f;
    float wa[16], ba = 0.f;
#pragma unroll
    for (int j = 0; j < 16; ++j) wa[j] = 0.f;
    if (tid < 256) {
#pragma unroll
        for (int j = 0; j < 16; ++j) wa[j] = w_alpha[j * 1024 + h * 256 + tid];
        ba = b_alpha[h * 256 + tid];
    }
    for (int t = 0; t < SEQ; ++t) {
        const size_t row = (size_t)b * SEQ + t;
        bf16_t* pr = P + row * NP;
        if (tid < 256) {
            const int kk = h * 256 + tid;
            float x = ba;
#pragma unroll
            for (int j = 0; j < 16; ++j) x += R[row * 16 + j] * wa[j];
            sa[tid] = expf(logsigmoidf_(x) * (1.f / 16.f));
            sq[tid] = bf2f(pr[kk]) * (1.f / 16.f);
            sk[tid] = bf2f(pr[1024 + kk]);
        }
        const int vc = 2048 + h * 512 + half * 256 + v;
        const float vv = bf2f(pr[vc]);
        __syncthreads();
        float part = 0.f;
#pragma unroll
        for (int j = 0; j < 128; ++j) { const int k = kh * 128 + j; S[j] = sa[k] * S[j] + sk[k] * vv; part += sq[k] * S[j]; }
        sred[kh][v] = part;
        __syncthreads();
        if (tid < 256) pr[vc] = f2bf(sred[0][v] + sred[1][v]);
    }
}

__global__ __launch_bounds__(256) void k_headnorm1(bf16_t* P, const float* head_g) {
    const int lane = threadIdx.x & 63, wv = threadIdx.x >> 6;
    const int item = blockIdx.x * 4 + wv;
    const int row = item >> 2, h = item & 3;
    bf16_t* pr = P + (size_t)row * NP;
    float val[8]; float ss = 0.f;
#pragma unroll
    for (int e = 0; e < 8; ++e) { const int c = h * 512 + lane * 8 + e; val[e] = bf2f(pr[2048 + c]); ss += val[e] * val[e]; }
    ss = wave_sum(ss);
    const float inv = rsqrtf(ss * (1.f / 512.f) + EPS);
#pragma unroll
    for (int e = 0; e < 8; ++e) { const int c = h * 512 + lane * 8 + e; pr[4096 + c] = f2bf(val[e] * inv * head_g[c] * siluf_(bf2f(pr[4096 + c]))); }
}

__global__ __launch_bounds__(256) void k_final(float* X, const float* g) {
    const int lane = threadIdx.x & 63, wv = threadIdx.x >> 6;
    const int row = blockIdx.x * 4 + wv;
    float* xr = X + (size_t)row * DM;
    float4 v[4]; float ss = 0.f;
#pragma unroll
    for (int j = 0; j < 4; ++j) { v[j] = *(const float4*)(xr + j * 256 + lane * 4); ss += v[j].x * v[j].x + v[j].y * v[j].y + v[j].z * v[j].z + v[j].w * v[j].w; }
    ss = wave_sum(ss);
    const float inv = rsqrtf(ss * (1.f / DM) + EPS);
#pragma unroll
    for (int j = 0; j < 4; ++j) {
        const float4 gg = *(const float4*)(g + j * 256 + lane * 4);
        float4 o; o.x = v[j].x * inv * gg.x; o.y = v[j].y * inv * gg.y; o.z = v[j].z * inv * gg.z; o.w = v[j].w * inv * gg.w;
        *(float4*)(xr + j * 256 + lane * 4) = o;
    }
}

extern "C" void kernel_launch(void* const* d_in, const int* in_sizes, int n_in, void* d_out, int out_size, void* d_ws, size_t ws_size, hipStream_t stream) {
    const float* x = (const float*)d_in[0];
    const float* norm_g = (const float*)d_in[1];
    const float* final_g = (const float*)d_in[2];
    const float* ev_w_in = (const float*)d_in[3];
    const float* conv_w = (const float*)d_in[4];
    const float* conv_b = (const float*)d_in[5];
    const float* i_bias = (const float*)d_in[6];
    const float* f_bias = (const float*)d_in[7];
    const float* ev_head_g = (const float*)d_in[8];
    const float* lam_re = (const float*)d_in[9];
    const float* lam_im = (const float*)d_in[10];
    const float* log_dt = (const float*)d_in[11];
    const float* b_re = (const float*)d_in[12];
    const float* b_im = (const float*)d_in[13];
    const float* c_re = (const float*)d_in[14];
    const float* c_im = (const float*)d_in[15];
    const float* s5_d = (const float*)d_in[16];
    const float* glu_w = (const float*)d_in[17];
    const float* glu_b = (const float*)d_in[18];
    const float* ev_w_out = (const float*)d_in[19];
    const float* od_w_in = (const float*)d_in[20];
    const float* w_alpha = (const float*)d_in[21];
    const float* b_alpha = (const float*)d_in[22];
    const float* gla_head_g = (const float*)d_in[23];
    const float* od_w_out = (const float*)d_in[24];
    float* out = (float*)d_out;
    unsigned char* ws = (unsigned char*)d_ws;
    bf16_t* WIN = (bf16_t*)(ws + WS_WIN); bf16_t* WGLU = (bf16_t*)(ws + WS_WGLU); bf16_t* WOUT0 = (bf16_t*)(ws + WS_WOUT0); bf16_t* WOUT1 = (bf16_t*)(ws + WS_WOUT1);
    bf16_t* HN = (bf16_t*)(ws + WS_HN); bf16_t* P = (bf16_t*)(ws + WS_P);
    float* GIF = (float*)(ws + WS_GIF); float* R = (float*)(ws + WS_R); float* RSQ0 = (float*)(ws + WS_RSQ0); float* RSQ1 = (float*)(ws + WS_RSQ1);

    k_convT<<<dim3(6144 / 32, 1024 / 32), 256, 0, stream>>>(ev_w_in, 6152, 1024, 6144, norm_g, 1, WIN);
    k_convT<<<dim3(1024 / 32, 1024 / 32), 256, 0, stream>>>(glu_w, 1024, 1024, 1024, nullptr, 0, WGLU);
    k_convT<<<dim3(1024 / 32, 2048 / 32), 256, 0, stream>>>(ev_w_out, 1024, 2048, 1024, nullptr, 0, WOUT0);
    k_convT<<<dim3(1024 / 32, 2048 / 32), 256, 0, stream>>>(od_w_out, 1024, 2048, 1024, nullptr, 0, WOUT1);
    k_rows<8><<<M_ / 4, 256, 0, stream>>>(x, norm_g, ev_w_in, 6152, 3072, i_bias, f_bias, HN, RSQ0, GIF);
    k_gemm<EpiProj><<<dim3(6144 / 64, M_ / 64), 256, 0, stream>>>(HN, 1024, WIN, 1024, 1024, EpiProj{P, RSQ0});
    k_mlstm_naive<<<32, 1024, 0, stream>>>(P, GIF, conv_w, conv_b);
    k_headnorm0<<<M_, 256, 0, stream>>>(P, ev_head_g);
    k_s5_naive<<<512, 64, 0, stream>>>(P, lam_re, lam_im, log_dt, b_re, b_im, c_re, c_im, s5_d);
    k_gemm<EpiGlu><<<dim3(1024 / 64, M_ / 64), 256, 0, stream>>>(P + 2048, NP, WGLU, 1024, 1024, EpiGlu{P, glu_b});
    k_gemm<EpiRes><<<dim3(1024 / 64, M_ / 64), 256, 0, stream>>>(P + 3072, NP, WOUT0, 2048, 2048, EpiRes{x, out});
    k_convT<<<dim3(6144 / 32, 1024 / 32), 256, 0, stream>>>(od_w_in, 6160, 1024, 6144, norm_g + 1024, 0, WIN);
    k_rows<16><<<M_ / 4, 256, 0, stream>>>(out, norm_g + 1024, od_w_in, 6160, 6144, nullptr, nullptr, HN, RSQ1, R);
    k_gemm<EpiProj><<<dim3(6144 / 64, M_ / 64), 256, 0, stream>>>(HN, 1024, WIN, 1024, 1024, EpiProj{P, RSQ1});
    k_gla_naive<<<64, 512, 0, stream>>>(P, R, w_alpha, b_alpha);
    k_headnorm1<<<M_, 256, 0, stream>>>(P, gla_head_g);
    k_gemm<EpiRes><<<dim3(1024 / 64, M_ / 64), 256, 0, stream>>>(P + 4096, NP, WOUT1, 2048, 2048, EpiRes{out, out});
    k_final<<<M_ / 4, 256, 0, stream>>>(out, final_g);
}
```

```cpp
#include <hip/hip_runtime.h>
#include <hip/hip_cooperative_groups.h>
#include <cstdio>
#include <cstdint>
namespace cg = cooperative_groups;

typedef unsigned short bf16_t;
#define LAS __attribute__((address_space(3)))
typedef short bf16x8 __attribute__((ext_vector_type(8)));
typedef float f32x4 __attribute__((ext_vector_type(4)));
typedef float f32x2 __attribute__((ext_vector_type(2)));
typedef unsigned u32x4 __attribute__((ext_vector_type(4)));
typedef unsigned u32x2 __attribute__((ext_vector_type(2)));

constexpr int BATCH = 8, SEQ = 2048, DM = 1024, M_ = BATCH * SEQ;
constexpr int NP = 6144;
constexpr float EPS = 1e-6f;
constexpr int NWAVES = 8, NTHREADS = 512;

constexpr size_t MiB = 1u << 20;
constexpr size_t WS_WIN = 1 * MiB;
constexpr size_t WS_WGLU = 13 * MiB;
constexpr size_t WS_WOUT0 = 15 * MiB;
constexpr size_t WS_WOUT1 = 19 * MiB;
constexpr size_t WS_HN = 23 * MiB;
constexpr size_t WS_P = 55 * MiB;
constexpr size_t WS_GIF = 247 * MiB;
constexpr size_t WS_R = 248 * MiB;
constexpr size_t WS_RSQ0 = 249 * MiB;
constexpr size_t WS_RSQ1 = 249 * MiB + 65536;

constexpr int RING_BYTES = 131072;
constexpr int LDS_BYTES = 135168;

__device__ __forceinline__ float bf2f(bf16_t v) { return __uint_as_float(((unsigned)v) << 16); }
__device__ __forceinline__ bf16_t f2bf(float f) { unsigned u = __float_as_uint(f); u += 0x7fffu + ((u >> 16) & 1u); return (bf16_t)(u >> 16); }
__device__ __forceinline__ unsigned pk2(float lo, float hi) { return (unsigned)f2bf(lo) | ((unsigned)f2bf(hi) << 16); }
__device__ __forceinline__ float sigmoidf_(float x) { return 1.f / (1.f + __expf(-x)); }
__device__ __forceinline__ float siluf_(float x) { return x * sigmoidf_(x); }
__device__ __forceinline__ float logsigmoidf_(float x) { return fminf(x, 0.f) - log1pf(expf(-fabsf(x))); }
__device__ __forceinline__ float gelu_tanh(float x) { const float c = 0.7978845608028654f; float u = c * (x + 0.044715f * x * x * x); return 0.5f * x * (1.f + tanhf(u)); }
__device__ __forceinline__ float wave_sum(float v) {
#pragma unroll
    for (int o = 1; o < 64; o <<= 1) v += __shfl_xor(v, o);
    return v;
}
__device__ __forceinline__ float bflo(unsigned w) { return __uint_as_float(w << 16); }
__device__ __forceinline__ float bfhi(unsigned w) { return __uint_as_float(w & 0xffff0000u); }

namespace pg8 {
constexpr int BM = 256, BK = 64, HALF = 128, HTB = HALF * BK * 2, STAGE_BYTES = 8 * HTB, NXCD = 8, WGM = 8;
__host__ __device__ __forceinline__ int lds_byte(int r, int c) { const int st = (r >> 4) * 2 + (c >> 5), rr = r & 15, cc = c & 31, ob = rr * 64 + cc * 2; return st * 1024 + (ob ^ (((ob >> 9) & 1) << 5)); }
__host__ __device__ __forceinline__ void stage_rc(int b, int& R, int& C) { const int st = b / 1024, sb = b % 1024, swz = sb ^ (((sb >> 9) & 1) << 5); R = (st >> 1) * 16 + swz / 64; C = (st & 1) * 32 + (swz % 64) / 2; }
__host__ __device__ __forceinline__ int perm32(int rho) { const int n = rho >> 4, i = rho & 15; return 8 * (i >> 2) + 4 * n + (i & 3); }

struct Unit { int pm, pn; };
struct Gemm { const bf16_t* A; int lda; const bf16_t* Bt; int M, N, K; };

struct StaticOrder {
    int nM, nN, nwg, G, c;
    __host__ __device__ void init(int M, int N, int G_, int c_) { nM = M / BM; nN = N / BM; nwg = nM * nN; G = G_; c = c_; }
    __host__ __device__ bool next(int i, Unit& u) const {
        const long L = (long)i * G + c; if (L >= nwg) return false;
        int wgid = (int)L; { const int q = nwg / NXCD, r = nwg % NXCD, xcd = wgid % NXCD, off = wgid / NXCD; wgid = (xcd < r ? xcd * (q + 1) : r * (q + 1) + (xcd - r) * q) + off; }
        const int nig = WGM * nN, gid = wgid / nig, fm = gid * WGM, gsz = (nM - fm) < WGM ? (nM - fm) : WGM;
        u.pm = fm + ((wgid % nig) % gsz); u.pn = (wgid % nig) / gsz; return true;
    }
};

struct EpiProj {
    static constexpr bool PERM = true;
    bf16_t* P; const float* rowsq;
    __device__ __forceinline__ void operator()(const f32x4 (&acc)[2][2][4][2], const Unit& u, int wr, int wc, int fr, int fq) const {
        const int row0 = u.pm * BM + wr * 64 + fr, col0 = u.pn * BM + wc * 32 + 8 * fq;
#pragma unroll
        for (int ai = 0; ai < 2; ++ai)
#pragma unroll
            for (int m = 0; m < 4; ++m) {
                const int row = row0 + ai * HALF + m * 16;
                const float inv = rsqrtf(rowsq[row] * (1.f / DM) + EPS);
                bf16_t* rowp = P + (size_t)row * NP + col0;
#pragma unroll
                for (int bj = 0; bj < 2; ++bj) {
                    const f32x4 v0 = acc[ai][bj][m][0] * inv, v1 = acc[ai][bj][m][1] * inv;
                    u32x4 w; w.x = pk2(v0[0], v0[1]); w.y = pk2(v0[2], v0[3]); w.z = pk2(v1[0], v1[1]); w.w = pk2(v1[2], v1[3]);
                    *(u32x4*)(rowp + bj * HALF) = w;
                }
            }
    }
};
struct EpiGlu {
    static constexpr bool PERM = true;
    bf16_t* P; const float* bias;
    __device__ __forceinline__ void operator()(const f32x4 (&acc)[2][2][4][2], const Unit& u, int wr, int wc, int fr, int fq) const {
        const int row0 = u.pm * BM + wr * 64 + fr, col0 = u.pn * BM + wc * 32 + 8 * fq;
        f32x4 bv[2][2];
#pragma unroll
        for (int bj = 0; bj < 2; ++bj)
#pragma unroll
            for (int n = 0; n < 2; ++n) bv[bj][n] = *(const f32x4*)(bias + col0 + bj * HALF + 4 * n);
#pragma unroll
        for (int ai = 0; ai < 2; ++ai)
#pragma unroll
            for (int m = 0; m < 4; ++m) {
                const int row = row0 + ai * HALF + m * 16;
                bf16_t* rowp = P + (size_t)row * NP + col0;
#pragma unroll
                for (int bj = 0; bj < 2; ++bj) {
                    const u32x4 yg = *(const u32x4*)(rowp + 2048 + bj * HALF);
                    const u32x4 zb = *(const u32x4*)(rowp + 4096 + bj * HALF);
                    const f32x4 s0 = acc[ai][bj][m][0] + bv[bj][0], s1 = acc[ai][bj][m][1] + bv[bj][1];
                    float o[8];
                    const unsigned yw[4] = {yg.x, yg.y, yg.z, yg.w}, zw[4] = {zb.x, zb.y, zb.z, zb.w};
#pragma unroll
                    for (int e = 0; e < 4; ++e) {
                        const float sa = (e < 2) ? s0[2 * e] : s1[2 * e - 4], sb = (e < 2) ? s0[2 * e + 1] : s1[2 * e - 3];
                        o[2 * e] = bflo(yw[e]) * sigmoidf_(sa) * siluf_(bflo(zw[e]));
                        o[2 * e + 1] = bfhi(yw[e]) * sigmoidf_(sb) * siluf_(bfhi(zw[e]));
                    }
                    u32x4 w; w.x = pk2(o[0], o[1]); w.y = pk2(o[2], o[3]); w.z = pk2(o[4], o[5]); w.w = pk2(o[6], o[7]);
                    *(u32x4*)(rowp + 4096 + bj * HALF) = w;
                }
            }
    }
};
struct EpiRes {
    static constexpr bool PERM = false;
    const float* X; float* O;
    __device__ __forceinline__ void operator()(const f32x4 (&acc)[2][2][4][2], const Unit& u, int wr, int wc, int fr, int fq) const {
        const int row0 = u.pm * BM + wr * 64 + fr, col0 = u.pn * BM + wc * 32 + 4 * fq;
#pragma unroll
        for (int ai = 0; ai < 2; ++ai)
#pragma unroll
            for (int m = 0; m < 4; ++m) {
                const size_t off = (size_t)(row0 + ai * HALF + m * 16) * DM + col0;
#pragma unroll
                for (int bj = 0; bj < 2; ++bj)
#pragma unroll
                    for (int n = 0; n < 2; ++n) {
                        const f32x4 xv = *(const f32x4*)(X + off + bj * HALF + n * 16);
                        *(f32x4*)(O + off + bj * HALF + n * 16) = xv + acc[ai][bj][m][n];
                    }
            }
    }
};

template <class Epi, bool ALIGN_EPI = true>
__device__ __forceinline__ void gemm_phase(LAS unsigned char* lds, const Gemm g, const StaticOrder& S, const Epi& E) {
    int tid_ = threadIdx.x; asm volatile("" : "+v"(tid_));
    const int tid = tid_, wid = __builtin_amdgcn_readfirstlane(tid >> 6), lane = tid & 63, wr = wid >> 2, wc = wid & 3, fr = lane & 15, fq = lane >> 4;
    const int K = g.K, nt = K / BK, lda = g.lda;
    unsigned voffA[2], voffB[2];
#pragma unroll
    for (int i = 0; i < 2; ++i) { int R, C; stage_rc(tid * 16 + i * 8192, R, C); const int Rb = Epi::PERM ? ((R & ~31) + perm32(R & 31)) : R;
        voffA[i] = (unsigned)(R * lda + C) * 2u; voffB[i] = (unsigned)(Rb * K + C) * 2u; }
    const size_t kstep = (size_t)(BK * 2);
    const size_t hstepA = (size_t)HALF * lda * 2, hstepB = (size_t)HALF * K * 2;
    const size_t tstepA = 2 * hstepA, tstepB = 2 * hstepB;
    const unsigned ldsw = (unsigned)wid * 1024u;
    const int aoff = lds_byte(wr * 64 + fr, fq * 8), boff = lds_byte(wc * 32 + fr, fq * 8);
#define PG8_SA(b, h) (((b) * 2 + (h)) * HTB)
#define PG8_SB(b, h) ((4 + (b) * 2 + (h)) * HTB)
#define PG8_STAGE(bufoff, gbase, voff) do { _Pragma("unroll") for (int _i = 0; _i < 2; ++_i) \
        __builtin_amdgcn_global_load_lds((const unsigned*)((const char*)(gbase) + (voff)[_i]), (LAS unsigned*)(lds + (bufoff) + ldsw + _i * 8192), 16, 0, 0); } while (0)
#define PG8_LDA(dst, b, h) do { _Pragma("unroll") for (int m = 0; m < 4; ++m) _Pragma("unroll") for (int k = 0; k < 2; ++k) dst[m][k] = *(const LAS bf16x8*)(lds + PG8_SA(b, h) + aoff + m * 2048 + k * 1024); } while (0)
#define PG8_LDB(dst, b, h) do { _Pragma("unroll") for (int n = 0; n < 2; ++n) _Pragma("unroll") for (int k = 0; k < 2; ++k) dst[n][k] = *(const LAS bf16x8*)(lds + PG8_SB(b, h) + boff + n * 2048 + k * 1024); } while (0)
#define PG8_MMA(ai, bj, At, Bt) do { __builtin_amdgcn_s_setprio(1); _Pragma("unroll") for (int m = 0; m < 4; ++m) _Pragma("unroll") for (int n = 0; n < 2; ++n) _Pragma("unroll") for (int k = 0; k < 2; ++k) \
        acc[ai][bj][m][n] = __builtin_amdgcn_mfma_f32_16x16x32_bf16(Bt[n][k], At[m][k], acc[ai][bj][m][n], 0, 0, 0); __builtin_amdgcn_s_setprio(0); } while (0)
#define PG8_WAIT_V(n) asm volatile("s_waitcnt vmcnt(" #n ")" ::: "memory")
#define PG8_WAIT_L(n) asm volatile("s_waitcnt lgkmcnt(" #n ")" ::: "memory")
#define PG8_BAR __builtin_amdgcn_s_barrier()
#define PG8_SCHED __builtin_amdgcn_sched_barrier(0)
    Unit cur, nxt; int ui = 0;
    if (!S.next(0, cur)) return;
    f32x4 acc[2][2][4][2];
#pragma unroll
    for (int a = 0; a < 2; ++a)
#pragma unroll
        for (int b = 0; b < 2; ++b)
#pragma unroll
            for (int m = 0; m < 4; ++m)
#pragma unroll
                for (int n = 0; n < 2; ++n) acc[a][b][m][n] = (f32x4){0.f, 0.f, 0.f, 0.f};
    bf16x8 At[4][2], B0[2][2], B1[2][2];
    const char* cA = (const char*)g.A + (size_t)cur.pm * tstepA; const char* cB = (const char*)g.Bt + (size_t)cur.pn * tstepB;
    PG8_STAGE(PG8_SB(0, 0), cB, voffB); PG8_STAGE(PG8_SB(0, 1), cB + hstepB, voffB); PG8_STAGE(PG8_SA(0, 0), cA, voffA); PG8_STAGE(PG8_SA(0, 1), cA + hstepA, voffA);
    if (wr == 1) PG8_BAR;
    PG8_WAIT_V(2); PG8_BAR;
    PG8_STAGE(PG8_SB(1, 0), cB + kstep, voffB); PG8_STAGE(PG8_SA(1, 0), cA + kstep, voffA); PG8_STAGE(PG8_SB(1, 1), cB + hstepB + kstep, voffB);
    PG8_WAIT_V(6); PG8_BAR;
    for (;;) {
        const bool has_next = S.next(ui + 1, nxt);
        const char* nA = has_next ? (const char*)g.A + (size_t)nxt.pm * tstepA : cA; const char* nB = has_next ? (const char*)g.Bt + (size_t)nxt.pn * tstepB : cB;
        for (int t = 0; t < nt; t += 2) {
            const bool last = (t == nt - 2);
            const char* a1 = cA + (size_t)(t + 1) * kstep;
            const char* a2 = last ? nA : cA + (size_t)(t + 2) * kstep; const char* b2 = last ? nB : cB + (size_t)(t + 2) * kstep;
            const char* a3 = a2 + kstep; const char* b3 = b2 + kstep;
            PG8_LDB(B0, 0, 0); PG8_LDB(B1, 0, 1); PG8_SCHED; PG8_LDA(At, 0, 0); PG8_STAGE(PG8_SA(1, 1), a1 + hstepA, voffA);
            PG8_WAIT_V(8); PG8_WAIT_L(0); PG8_BAR; PG8_MMA(0, 0, At, B0); PG8_MMA(0, 1, At, B1); PG8_BAR; PG8_SCHED;
            PG8_LDA(At, 0, 1); PG8_STAGE(PG8_SB(0, 0), b2, voffB); PG8_STAGE(PG8_SB(0, 1), b2 + hstepB, voffB); PG8_STAGE(PG8_SA(0, 0), a2, voffA);
            PG8_WAIT_V(8); PG8_WAIT_L(0); PG8_BAR; PG8_MMA(1, 0, At, B0); PG8_MMA(1, 1, At, B1); PG8_BAR; PG8_SCHED;
            PG8_LDB(B0, 1, 0); PG8_LDB(B1, 1, 1); PG8_SCHED; PG8_LDA(At, 1, 0); PG8_STAGE(PG8_SA(0, 1), a2 + hstepA, voffA);
            PG8_WAIT_V(8); PG8_WAIT_L(0); PG8_BAR; PG8_MMA(0, 0, At, B0); PG8_MMA(0, 1, At, B1); PG8_BAR; PG8_SCHED;
            PG8_LDA(At, 1, 1); PG8_STAGE(PG8_SB(1, 0), b3, voffB); PG8_STAGE(PG8_SB(1, 1), b3 + hstepB, voffB); PG8_STAGE(PG8_SA(1, 0), a3, voffA);
            PG8_WAIT_V(8); PG8_WAIT_L(0); PG8_BAR; PG8_MMA(1, 0, At, B0); PG8_MMA(1, 1, At, B1); PG8_BAR; PG8_SCHED;
        }
        if constexpr (ALIGN_EPI) { if (wr == 0) PG8_BAR; }
        E(acc, cur, wr, wc, fr, fq);
        if (!has_next) break;
#pragma unroll
        for (int a = 0; a < 2; ++a)
#pragma unroll
            for (int b = 0; b < 2; ++b)
#pragma unroll
                for (int m = 0; m < 4; ++m)
#pragma unroll
                    for (int n = 0; n < 2; ++n) acc[a][b][m][n] = (f32x4){0.f, 0.f, 0.f, 0.f};
        cur = nxt; cA = nA; cB = nB; ++ui;
        if constexpr (ALIGN_EPI) { if (wr == 1) PG8_BAR; }
    }
    PG8_WAIT_V(0);
    if constexpr (!ALIGN_EPI) { if (wr == 0) PG8_BAR; }
    PG8_BAR;
#undef PG8_SA
#undef PG8_SB
#undef PG8_STAGE
#undef PG8_LDA
#undef PG8_LDB
#undef PG8_MMA
#undef PG8_WAIT_V
#undef PG8_WAIT_L
#undef PG8_BAR
#undef PG8_SCHED
}
}

struct Args {
    const float* in[25]; float* out; unsigned char* ws;
};

__device__ __forceinline__ void transpose_item(const float* W, int ldw, int K, const float* scale, bf16_t* WT, int k0, int n0, int c0, LAS float* scr, int lane) {
#pragma unroll 8
    for (int i = 0; i < 32; ++i) { const int kk = 2 * i + (lane >> 5); float w = W[(size_t)(k0 + kk) * ldw + c0 + (lane & 31)]; if (scale) w *= scale[k0 + kk]; scr[kk * 33 + (lane & 31)] = w; }
    asm volatile("s_waitcnt lgkmcnt(0)" ::: "memory");
    const int c = lane & 7;
#pragma unroll
    for (int j = 0; j < 4; ++j) { const int n = (lane >> 3) + 8 * j; const LAS float* s = scr + (8 * c) * 33 + n;
        u32x4 o; o.x = pk2(s[0 * 33], s[1 * 33]); o.y = pk2(s[2 * 33], s[3 * 33]); o.z = pk2(s[4 * 33], s[5 * 33]); o.w = pk2(s[6 * 33], s[7 * 33]);
        *(u32x4*)(WT + (size_t)(n0 + n) * K + k0 + 8 * c) = o; }
    asm volatile("s_waitcnt lgkmcnt(0)" ::: "memory");
}
__device__ __forceinline__ int colmap0(int n) {
    if (n < 2048) return n;
    if (n < 3072) return 3080 + (n - 2048);
    if (n < 4096) return 2048 + (n - 3072);
    if (n < 5120) return 5128 + (n - 4096);
    return 4104 + (n - 5120);
}
__device__ __forceinline__ void convert_weight(const float* W, int ldw, int K, int N, const float* scale, int mode, bf16_t* WT, LAS float* scr, int gw, int ngw, int lane) {
    const int nblk = N / 32, nitems = (K / 64) * nblk;
    for (int it = gw; it < nitems; it += ngw) {
        const int kb = it / nblk, nb = it % nblk, n0 = nb * 32;
        transpose_item(W, ldw, K, scale, WT, kb * 64, n0, mode ? colmap0(n0) : n0, scr, lane);
    }
}

template <int NC>
__device__ __forceinline__ void rows_prep(const float* X, const float* g, const float* W, int ldw, int col0, const float* bias_a, const float* bias_b,
                                          bf16_t* HN, float* rowsq, float* G, int gw, int ngw, int lane) {
    for (int row = gw; row < M_; row += ngw) {
        const float* xr = X + (size_t)row * DM;
        float d[NC];
#pragma unroll
        for (int c = 0; c < NC; ++c) d[c] = 0.f;
        float ss = 0.f;
#pragma unroll 1
        for (int j = 0; j < 4; ++j) {
            const f32x4 v = *(const f32x4*)(xr + j * 256 + lane * 4);
            ss += v[0] * v[0] + v[1] * v[1] + v[2] * v[2] + v[3] * v[3];
            u32x2 o; o.x = pk2(v[0], v[1]); o.y = pk2(v[2], v[3]);
            *(u32x2*)(HN + (size_t)row * DM + j * 256 + lane * 4) = o;
            const f32x4 gg = *(const f32x4*)(g + j * 256 + lane * 4);
#pragma unroll
            for (int e = 0; e < 4; ++e) {
                const float xv = v[e] * gg[e];
                const float* wr = W + (size_t)(j * 256 + lane * 4 + e) * ldw + col0;
#pragma unroll
                for (int c = 0; c < NC; ++c) d[c] += xv * wr[c];
            }
        }
        ss = wave_sum(ss);
        const float inv = rsqrtf(ss * (1.f / DM) + EPS);
        if (lane == 0) rowsq[row] = ss;
#pragma unroll
        for (int c = 0; c < NC; ++c) {
            float s = wave_sum(d[c]) * inv;
            if (bias_a) s += (c < NC / 2) ? bias_a[c] : bias_b[c - NC / 2];
            if (lane == 0) G[(size_t)row * NC + c] = s;
        }
    }
}

__device__ __forceinline__ void mlstm_naive(bf16_t* P, const float* gif, const float* conv_w, const float* conv_b, const float* head_g, LAS float* sm, int item) {
    const int b = item >> 2, h = item & 3;
    const int tid = threadIdx.x, v = tid & 255, kq = tid >> 8;
    LAS float* sq = sm; LAS float* sk = sm + 128; LAS float* sred = sm + 256; LAS float* sden = sm + 768; LAS float* sss = sm + 772;
    float C[64];
#pragma unroll
    for (int j = 0; j < 64; ++j) C[j] = 0.f;
    float nst = 0.f, m = -1e30f;
    int ch = 0; float w0 = 0, w1 = 0, w2 = 0, w3 = 0, cb = 0, r0 = 0, r1 = 0, r2 = 0, hg = 0;
    if (tid < 256) {
        ch = (tid < 128) ? (h * 128 + tid) : (512 + h * 128 + (tid - 128));
        w0 = conv_w[0 * 1024 + ch]; w1 = conv_w[1 * 1024 + ch]; w2 = conv_w[2 * 1024 + ch]; w3 = conv_w[3 * 1024 + ch]; cb = conv_b[ch];
        hg = head_g[h * 256 + v];
    }
    const float qscale = 0.08838834764831845f;
    for (int t = 0; t < SEQ; ++t) {
        const size_t row = (size_t)b * SEQ + t;
        bf16_t* pr = P + row * NP;
        if (tid < 256) {
            const float raw = bf2f(pr[ch]);
            const float cv = w0 * r0 + w1 * r1 + w2 * r2 + w3 * raw + cb;
            r0 = r1; r1 = r2; r2 = raw;
            const float val = siluf_(cv);
            if (tid < 128) sq[tid] = val * qscale; else sk[tid - 128] = val;
        }
        const float ip = gif[row * 8 + h], fp = gif[row * 8 + 4 + h];
        const float logf = logsigmoidf_(fp);
        const float mn = fmaxf(logf + m, ip);
        const float fs = expf(logf + m - mn), is = expf(ip - mn);
        m = mn;
        const float vv = bf2f(pr[1024 + h * 256 + v]);
        __syncthreads();
        float part = 0.f;
#pragma unroll
        for (int j = 0; j < 64; ++j) { const int k = kq * 64 + j; C[j] = fs * C[j] + is * sk[k] * vv; part += C[j] * sq[k]; }
        sred[kq * 256 + v] = part;
        if (tid < 128) {
            nst = fs * nst + is * sk[tid];
            const float dp = wave_sum(nst * sq[tid]);
            if ((tid & 63) == 0) sden[tid >> 6] = dp;
        }
        __syncthreads();
        float val = 0.f;
        if (tid < 256) {
            const float num = sred[v] + sred[256 + v];
            const float den = sden[0] + sden[1];
            const float hv = num / fmaxf(fabsf(den), expf(-m));
            val = sigmoidf_(bf2f(pr[3072 + h * 256 + v])) * hv;
            const float s2 = wave_sum(val * val);
            if ((tid & 63) == 0) sss[tid >> 6] = s2;
        }
        __syncthreads();
        if (tid < 256) {
            const float inv = rsqrtf((sss[0] + sss[1] + sss[2] + sss[3]) * (1.f / 256.f) + EPS);
            pr[3072 + h * 256 + v] = f2bf(val * inv * hg * siluf_(bf2f(pr[5120 + h * 256 + v])));
        }
    }
    __syncthreads();
}

__device__ __forceinline__ void s5_naive(bf16_t* P, const float* lam_re, const float* lam_im, const float* log_dt, const float* b_re, const float* b_im,
                                         const float* c_re, const float* c_im, const float* dskip, int item, int p) {
    const int b = item >> 6, g = item & 63;
    const float lr = lam_re[g * 64 + p], li = lam_im[g * 64 + p], dt = expf(log_dt[g]);
    const float ex = expf(lr * dt), cs = cosf(li * dt), sn = sinf(li * dt);
    const float ar = ex * cs, ai = ex * sn;
    const float s2 = sinf(0.5f * li * dt);
    const float a1r = expm1f(lr * dt) * cs - 2.f * s2 * s2, a1i = ai;
    const float den = lr * lr + li * li;
    const float qr = (a1r * lr + a1i * li) / den, qi = (a1i * lr - a1r * li) / den;
    float bbr[16], bbi[16], cr[16], ci[16];
#pragma unroll
    for (int c = 0; c < 16; ++c) {
        const float br = b_re[(size_t)(g * 64 + p) * 16 + c], bi = b_im[(size_t)(g * 64 + p) * 16 + c];
        bbr[c] = br * qr - bi * qi; bbi[c] = br * qi + bi * qr;
        cr[c] = c_re[(size_t)(g * 16 + c) * 64 + p]; ci[c] = c_im[(size_t)(g * 16 + c) * 64 + p];
    }
    const float dd = dskip[g * 16 + (p & 15)];
    float xr = 0.f, xi = 0.f;
    for (int t = 0; t < SEQ; ++t) {
        bf16_t* pu = P + ((size_t)b * SEQ + t) * NP + 2048 + g * 16;
        float u[16];
#pragma unroll
        for (int c = 0; c < 16; ++c) u[c] = bf2f(pu[c]);
        const float up = bf2f(pu[p & 15]);
        float bur = 0.f, bui = 0.f;
#pragma unroll
        for (int c = 0; c < 16; ++c) { bur += bbr[c] * u[c]; bui += bbi[c] * u[c]; }
        const float nxr = ar * xr - ai * xi + bur, nxi = ar * xi + ai * xr + bui;
        xr = nxr; xi = nxi;
        float my = 0.f;
#pragma unroll
        for (int c = 0; c < 16; ++c) { const float yc = wave_sum(cr[c] * xr - ci[c] * xi); my = (p == c) ? yc : my; }
        if (p < 16) pu[p] = f2bf(gelu_tanh(my + dd * up));
    }
}

__device__ __forceinline__ void gla_naive(bf16_t* P, const float* R, const float* w_alpha, const float* b_alpha, LAS float* sm, int item) {
    const int b = item >> 3, h = (item >> 1) & 3, half = item & 1;
    const int tid = threadIdx.x, v = tid & 255, kh = tid >> 8;
    LAS float* sq = sm; LAS float* sk = sm + 256; LAS float* sa = sm + 512; LAS float* sred = sm + 768;
    float S[128];
#pragma unroll
    for (int j = 0; j < 128; ++j) S[j] = 0.f;
    float wa[16], ba = 0.f;
#pragma unroll
    for (int j = 0; j < 16; ++j) wa[j] = 0.f;
    if (tid < 256) {
#pragma unroll
        for (int j = 0; j < 16; ++j) wa[j] = w_alpha[j * 1024 + h * 256 + tid];
        ba = b_alpha[h * 256 + tid];
    }
    for (int t = 0; t < SEQ; ++t) {
        const size_t row = (size_t)b * SEQ + t;
        bf16_t* pr = P + row * NP;
        if (tid < 256) {
            const int kk = h * 256 + tid;
            float x = ba;
#pragma unroll
            for (int j = 0; j < 16; ++j) x += R[row * 16 + j] * wa[j];
            sa[tid] = expf(logsigmoidf_(x) * (1.f / 16.f));
            sq[tid] = bf2f(pr[kk]) * (1.f / 16.f);
            sk[tid] = bf2f(pr[1024 + kk]);
        }
        const int vc = 2048 + h * 512 + half * 256 + v;
        const float vv = bf2f(pr[vc]);
        __syncthreads();
        float part = 0.f;
#pragma unroll
        for (int j = 0; j < 128; ++j) { const int k = kh * 128 + j; S[j] = sa[k] * S[j] + sk[k] * vv; part += sq[k] * S[j]; }
        sred[kh * 256 + v] = part;
        __syncthreads();
        if (tid < 256) pr[vc] = f2bf(sred[v] + sred[256 + v]);
    }
    __syncthreads();
}

__device__ __forceinline__ void headnorm1(bf16_t* P, const float* head_g, int gw, int ngw, int lane) {
    for (int item = gw; item < M_ * 4; item += ngw) {
        const int row = item >> 2, h = item & 3;
        bf16_t* pr = P + (size_t)row * NP;
        const u32x4 ov = *(const u32x4*)(pr + 2048 + h * 512 + lane * 8);
        const u32x4 zv = *(const u32x4*)(pr + 4096 + h * 512 + lane * 8);
        const unsigned ow[4] = {ov.x, ov.y, ov.z, ov.w}, zw[4] = {zv.x, zv.y, zv.z, zv.w};
        float val[8]; float ss = 0.f;
#pragma unroll
        for (int e = 0; e < 4; ++e) { val[2 * e] = bflo(ow[e]); val[2 * e + 1] = bfhi(ow[e]); ss += val[2 * e] * val[2 * e] + val[2 * e + 1] * val[2 * e + 1]; }
        ss = wave_sum(ss);
        const float inv = rsqrtf(ss * (1.f / 512.f) + EPS);
        const f32x4 g0 = *(const f32x4*)(head_g + h * 512 + lane * 8), g1 = *(const f32x4*)(head_g + h * 512 + lane * 8 + 4);
        float o[8];
#pragma unroll
        for (int e = 0; e < 4; ++e) {
            const float ga = (e < 2) ? g0[2 * e] : g1[2 * e - 4], gb = (e < 2) ? g0[2 * e + 1] : g1[2 * e - 3];
            o[2 * e] = val[2 * e] * inv * ga * siluf_(bflo(zw[e]));
            o[2 * e + 1] = val[2 * e + 1] * inv * gb * siluf_(bfhi(zw[e]));
        }
        u32x4 w; w.x = pk2(o[0], o[1]); w.y = pk2(o[2], o[3]); w.z = pk2(o[4], o[5]); w.w = pk2(o[6], o[7]);
        *(u32x4*)(pr + 4096 + h * 512 + lane * 8) = w;
    }
}

__device__ __forceinline__ void final_norm(float* X, const float* g, int gw, int ngw, int lane) {
    for (int row = gw; row < M_; row += ngw) {
        float* xr = X + (size_t)row * DM;
        f32x4 v[4]; float ss = 0.f;
#pragma unroll
        for (int j = 0; j < 4; ++j) { v[j] = *(const f32x4*)(xr + j * 256 + lane * 4); ss += v[j][0] * v[j][0] + v[j][1] * v[j][1] + v[j][2] * v[j][2] + v[j][3] * v[j][3]; }
        ss = wave_sum(ss);
        const float inv = rsqrtf(ss * (1.f / DM) + EPS);
#pragma unroll
        for (int j = 0; j < 4; ++j) { const f32x4 gg = *(const f32x4*)(g + j * 256 + lane * 4); *(f32x4*)(xr + j * 256 + lane * 4) = v[j] * inv * gg; }
    }
}

__global__ void __launch_bounds__(NTHREADS, 2) mega_fwd(Args a) {
    extern __shared__ __attribute__((aligned(16))) unsigned char lds_raw[];
    cg::grid_group grid = cg::this_grid();
    LAS unsigned char* lds = (LAS unsigned char*)lds_raw;
    const int tid = threadIdx.x, lane = tid & 63, wave = __builtin_amdgcn_readfirstlane(tid >> 6);
    const int G = gridDim.x, bx = blockIdx.x;
    const int gw = bx * NWAVES + wave, ngw = G * NWAVES;
    unsigned char* ws = a.ws;
    bf16_t* WIN = (bf16_t*)(ws + WS_WIN); bf16_t* WGLU = (bf16_t*)(ws + WS_WGLU); bf16_t* WOUT0 = (bf16_t*)(ws + WS_WOUT0); bf16_t* WOUT1 = (bf16_t*)(ws + WS_WOUT1);
    bf16_t* HN = (bf16_t*)(ws + WS_HN); bf16_t* P = (bf16_t*)(ws + WS_P);
    float* GIF = (float*)(ws + WS_GIF); float* R = (float*)(ws + WS_R); float* RSQ0 = (float*)(ws + WS_RSQ0); float* RSQ1 = (float*)(ws + WS_RSQ1);
    const float* x = a.in[0]; const float* norm_g = a.in[1]; float* out = a.out;
    LAS float* scr = (LAS float*)(lds + wave * 16384);

    convert_weight(a.in[3], 6152, 1024, 6144, norm_g, 1, WIN, scr, gw, ngw, lane);
    convert_weight(a.in[17], 1024, 1024, 1024, nullptr, 0, WGLU, scr, gw, ngw, lane);
    convert_weight(a.in[19], 1024, 2048, 1024, nullptr, 0, WOUT0, scr, gw, ngw, lane);
    convert_weight(a.in[24], 1024, 2048, 1024, nullptr, 0, WOUT1, scr, gw, ngw, lane);
    rows_prep<8>(x, norm_g, a.in[3], 6152, 3072, a.in[6], a.in[7], HN, RSQ0, GIF, gw, ngw, lane);
    grid.sync();
    { pg8::Gemm g{HN, DM, WIN, M_, 6144, 1024}; pg8::StaticOrder S; S.init(M_, 6144, G, bx); pg8::EpiProj E{P, RSQ0}; pg8::gemm_phase<pg8::EpiProj>(lds, g, S, E); }
    grid.sync();
    if (bx < 32) mlstm_naive(P, GIF, a.in[4], a.in[5], a.in[8], (LAS float*)lds, bx);
    else {
        const int w2 = (bx - 32) * NWAVES + wave, nw2 = (G - 32) * NWAVES;
        for (int it = w2; it < 512; it += nw2) s5_naive(P, a.in[9], a.in[10], a.in[11], a.in[12], a.in[13], a.in[14], a.in[15], a.in[16], it, lane);
        convert_weight(a.in[20], 6160, 1024, 6144, norm_g + 1024, 0, WIN, scr, w2, nw2, lane);
    }
    grid.sync();
    { pg8::Gemm g{P + 2048, NP, WGLU, M_, 1024, 1024}; pg8::StaticOrder S; S.init(M_, 1024, G, bx); pg8::EpiGlu E{P, a.in[18]}; pg8::gemm_phase<pg8::EpiGlu>(lds, g, S, E); }
    grid.sync();
    { pg8::Gemm g{P + 3072, NP, WOUT0, M_, 1024, 2048}; pg8::StaticOrder S; S.init(M_, 1024, G, bx); pg8::EpiRes E{x, out}; pg8::gemm_phase<pg8::EpiRes>(lds, g, S, E); }
    grid.sync();
    rows_prep<16>(out, norm_g + 1024, a.in[20], 6160, 6144, nullptr, nullptr, HN, RSQ1, R, gw, ngw, lane);
    grid.sync();
    { pg8::Gemm g{HN, DM, WIN, M_, 6144, 1024}; pg8::StaticOrder S; S.init(M_, 6144, G, bx); pg8::EpiProj E{P, RSQ1}; pg8::gemm_phase<pg8::EpiProj>(lds, g, S, E); }
    grid.sync();
    if (bx < 64) gla_naive(P, R, a.in[21], a.in[22], (LAS float*)lds, bx);
    grid.sync();
    headnorm1(P, a.in[23], gw, ngw, lane);
    grid.sync();
    { pg8::Gemm g{P + 4096, NP, WOUT1, M_, 1024, 2048}; pg8::StaticOrder S; S.init(M_, 1024, G, bx); pg8::EpiRes E{out, out}; pg8::gemm_phase<pg8::EpiRes>(lds, g, S, E); }
    grid.sync();
    final_norm(out, a.in[2], gw, ngw, lane);
}

extern "C" void kernel_launch(void* const* d_in, const int* in_sizes, int n_in, void* d_out, int out_size, void* d_ws, size_t ws_size, hipStream_t stream) {
    static int grid = 0;
    if (grid == 0) {
        int dev = 0, cus = 0, per_cu = 0;
        hipGetDevice(&dev);
        hipDeviceGetAttribute(&cus, hipDeviceAttributeMultiprocessorCount, dev);
        hipFuncSetAttribute((const void*)mega_fwd, hipFuncAttributeMaxDynamicSharedMemorySize, LDS_BYTES);
        hipOccupancyMaxActiveBlocksPerMultiprocessor(&per_cu, (const void*)mega_fwd, NTHREADS, LDS_BYTES);
        if (per_cu < 1) { fprintf(stderr, "kernel_launch: occupancy query reports %d blocks/CU\n", per_cu); per_cu = 1; }
        grid = cus;
        (void)hipGetLastError();
    }
    Args a{};
    for (int i = 0; i < 25; ++i) a.in[i] = (const float*)d_in[i];
    a.out = (float*)d_out; a.ws = (unsigned char*)d_ws;
    void* args[] = {&a};
    hipError_t e = hipLaunchCooperativeKernel((const void*)mega_fwd, dim3(grid), dim3(NTHREADS), args, LDS_BYTES, stream);
    if (e != hipSuccess) fprintf(stderr, "cooperative launch failed: %s (grid %d)\n", hipGetErrorString(e), grid);
}
```

```cpp
#include <hip/hip_runtime.h>
#include <cstdio>
#include <cstdint>

typedef unsigned short bf16_t;
#define LAS __attribute__((address_space(3)))
typedef short bf16x8 __attribute__((ext_vector_type(8)));
typedef float f32x4 __attribute__((ext_vector_type(4)));
typedef float f32x2 __attribute__((ext_vector_type(2)));
typedef unsigned u32x4 __attribute__((ext_vector_type(4)));
typedef unsigned u32x2 __attribute__((ext_vector_type(2)));

constexpr int BATCH = 8, SEQ = 2048, DM = 1024, M_ = BATCH * SEQ;
constexpr int NP = 6144;
constexpr float EPS = 1e-6f;
constexpr int NWAVES = 8, NTHREADS = 512;

constexpr size_t MiB = 1u << 20;
constexpr size_t WS_WIN = 1 * MiB;
constexpr size_t WS_WGLU = 13 * MiB;
constexpr size_t WS_WOUT0 = 15 * MiB;
constexpr size_t WS_WOUT1 = 19 * MiB;
constexpr size_t WS_HN = 23 * MiB;
constexpr size_t WS_P = 55 * MiB;
constexpr size_t WS_GIF = 247 * MiB;
constexpr size_t WS_R = 248 * MiB;
constexpr size_t WS_RSQ0 = 249 * MiB;
constexpr size_t WS_RSQ1 = 249 * MiB + 65536;

constexpr int RING_BYTES = 131072;
constexpr int LDS_BYTES = 135168;

__device__ __forceinline__ float bf2f(bf16_t v) { return __uint_as_float(((unsigned)v) << 16); }
typedef __bf16 bf16v2 __attribute__((ext_vector_type(2)));
__device__ __forceinline__ unsigned pk2(float lo, float hi) { const f32x2 v = {lo, hi}; return __builtin_bit_cast(unsigned, __builtin_convertvector(v, bf16v2)); }
__device__ __forceinline__ bf16_t f2bf(float f) { return (bf16_t)(pk2(f, 0.f) & 0xffffu); }
__device__ __forceinline__ float sigmoidf_(float x) { return 1.f / (1.f + __expf(-x)); }
__device__ __forceinline__ float siluf_(float x) { return x * sigmoidf_(x); }
__device__ __forceinline__ float logsigmoidf_(float x) { return fminf(x, 0.f) - __logf(1.f + __expf(-fabsf(x))); }
__device__ __forceinline__ float gelu_tanh(float x) { const float c = 0.7978845608028654f; float u = c * (x + 0.044715f * x * x * x); return 0.5f * x * (1.f + tanhf(u)); }
__device__ __forceinline__ float wave_sum(float v) {
#pragma unroll
    for (int o = 1; o < 64; o <<= 1) v += __shfl_xor(v, o);
    return v;
}
__device__ __forceinline__ float bflo(unsigned w) { return __uint_as_float(w << 16); }
__device__ __forceinline__ float bfhi(unsigned w) { return __uint_as_float(w & 0xffff0000u); }

namespace pg8 {
constexpr int BM = 256, BK = 64, HALF = 128, HTB = HALF * BK * 2, STAGE_BYTES = 8 * HTB, NXCD = 8, WGM = 8;
__host__ __device__ __forceinline__ int lds_byte(int r, int c) { const int st = (r >> 4) * 2 + (c >> 5), rr = r & 15, cc = c & 31, ob = rr * 64 + cc * 2; return st * 1024 + (ob ^ (((ob >> 9) & 1) << 5)); }
__host__ __device__ __forceinline__ void stage_rc(int b, int& R, int& C) { const int st = b / 1024, sb = b % 1024, swz = sb ^ (((sb >> 9) & 1) << 5); R = (st >> 1) * 16 + swz / 64; C = (st & 1) * 32 + (swz % 64) / 2; }
__host__ __device__ __forceinline__ int perm32(int rho) { const int n = rho >> 4, i = rho & 15; return 8 * (i >> 2) + 4 * n + (i & 3); }

struct Unit { int pm, pn; };
struct Gemm { const bf16_t* A; int lda; const bf16_t* Bt; int M, N, K; };

struct StaticOrder {
    int nM, nN, nwg, G, c;
    __host__ __device__ void init(int M, int N, int G_, int c_) { nM = M / BM; nN = N / BM; nwg = nM * nN; G = G_; c = c_; }
    __host__ __device__ bool next(int i, Unit& u) const {
        const long L = (long)i * G + c; if (L >= nwg) return false;
        int wgid = (int)L; { const int q = nwg / NXCD, r = nwg % NXCD, xcd = wgid % NXCD, off = wgid / NXCD; wgid = (xcd < r ? xcd * (q + 1) : r * (q + 1) + (xcd - r) * q) + off; }
        const int nig = WGM * nN, gid = wgid / nig, fm = gid * WGM, gsz = (nM - fm) < WGM ? (nM - fm) : WGM;
        u.pm = fm + ((wgid % nig) % gsz); u.pn = (wgid % nig) / gsz; return true;
    }
};

struct EpiProj {
    static constexpr bool PERM = true;
    bf16_t* P; const float* rowsq;
    __device__ __forceinline__ void operator()(const f32x4 (&acc)[2][2][4][2], const Unit& u, int wr, int wc, int fr, int fq) const {
        const int row0 = u.pm * BM + wr * 64 + fr, col0 = u.pn * BM + wc * 32 + 8 * fq;
#pragma unroll
        for (int ai = 0; ai < 2; ++ai)
#pragma unroll
            for (int m = 0; m < 4; ++m) {
                const int row = row0 + ai * HALF + m * 16;
                const float inv = rsqrtf(rowsq[row] * (1.f / DM) + EPS);
                bf16_t* rowp = P + (size_t)row * NP + col0;
#pragma unroll
                for (int bj = 0; bj < 2; ++bj) {
                    const f32x4 v0 = acc[ai][bj][m][0] * inv, v1 = acc[ai][bj][m][1] * inv;
                    u32x4 w; w.x = pk2(v0[0], v0[1]); w.y = pk2(v0[2], v0[3]); w.z = pk2(v1[0], v1[1]); w.w = pk2(v1[2], v1[3]);
                    *(u32x4*)(rowp + bj * HALF) = w;
                }
            }
    }
};
struct EpiGlu {
    static constexpr bool PERM = true;
    bf16_t* P; const float* bias;
    __device__ __forceinline__ void operator()(const f32x4 (&acc)[2][2][4][2], const Unit& u, int wr, int wc, int fr, int fq) const {
        const int row0 = u.pm * BM + wr * 64 + fr, col0 = u.pn * BM + wc * 32 + 8 * fq;
        f32x4 bv[2][2];
#pragma unroll
        for (int bj = 0; bj < 2; ++bj)
#pragma unroll
            for (int n = 0; n < 2; ++n) bv[bj][n] = *(const f32x4*)(bias + col0 + bj * HALF + 4 * n);
#pragma unroll
        for (int ai = 0; ai < 2; ++ai)
#pragma unroll
            for (int m = 0; m < 4; ++m) {
                const int row = row0 + ai * HALF + m * 16;
                bf16_t* rowp = P + (size_t)row * NP + col0;
#pragma unroll
                for (int bj = 0; bj < 2; ++bj) {
                    const u32x4 yg = *(const u32x4*)(rowp + 2048 + bj * HALF);
                    const u32x4 zb = *(const u32x4*)(rowp + 4096 + bj * HALF);
                    const f32x4 s0 = acc[ai][bj][m][0] + bv[bj][0], s1 = acc[ai][bj][m][1] + bv[bj][1];
                    float o[8];
                    const unsigned yw[4] = {yg.x, yg.y, yg.z, yg.w}, zw[4] = {zb.x, zb.y, zb.z, zb.w};
#pragma unroll
                    for (int e = 0; e < 4; ++e) {
                        const float sa = (e < 2) ? s0[2 * e] : s1[2 * e - 4], sb = (e < 2) ? s0[2 * e + 1] : s1[2 * e - 3];
                        o[2 * e] = bflo(yw[e]) * sigmoidf_(sa) * siluf_(bflo(zw[e]));
                        o[2 * e + 1] = bfhi(yw[e]) * sigmoidf_(sb) * siluf_(bfhi(zw[e]));
                    }
                    u32x4 w; w.x = pk2(o[0], o[1]); w.y = pk2(o[2], o[3]); w.z = pk2(o[4], o[5]); w.w = pk2(o[6], o[7]);
                    *(u32x4*)(rowp + 4096 + bj * HALF) = w;
                }
            }
    }
};
struct EpiRes {
    static constexpr bool PERM = false;
    const float* X; float* O;
    __device__ __forceinline__ void operator()(const f32x4 (&acc)[2][2][4][2], const Unit& u, int wr, int wc, int fr, int fq) const {
        const int row0 = u.pm * BM + wr * 64 + fr, col0 = u.pn * BM + wc * 32 + 4 * fq;
#pragma unroll
        for (int ai = 0; ai < 2; ++ai)
#pragma unroll
            for (int m = 0; m < 4; ++m) {
                const size_t off = (size_t)(row0 + ai * HALF + m * 16) * DM + col0;
#pragma unroll
                for (int bj = 0; bj < 2; ++bj)
#pragma unroll
                    for (int n = 0; n < 2; ++n) {
                        const f32x4 xv = *(const f32x4*)(X + off + bj * HALF + n * 16);
                        *(f32x4*)(O + off + bj * HALF + n * 16) = xv + acc[ai][bj][m][n];
                    }
            }
    }
};

template <class Epi, bool ALIGN_EPI = true>
__device__ __forceinline__ void gemm_phase(LAS unsigned char* lds, const Gemm g, const StaticOrder& S, const Epi& E) {
    int tid_ = threadIdx.x; asm volatile("" : "+v"(tid_));
    const int tid = tid_, wid = __builtin_amdgcn_readfirstlane(tid >> 6), lane = tid & 63, wr = wid >> 2, wc = wid & 3, fr = lane & 15, fq = lane >> 4;
    const int K = g.K, nt = K / BK, lda = g.lda;
    unsigned voffA[2], voffB[2];
#pragma unroll
    for (int i = 0; i < 2; ++i) { int R, C; stage_rc(tid * 16 + i * 8192, R, C); const int Rb = Epi::PERM ? ((R & ~31) + perm32(R & 31)) : R;
        voffA[i] = (unsigned)(R * lda + C) * 2u; voffB[i] = (unsigned)(Rb * K + C) * 2u; }
    const size_t kstep = (size_t)(BK * 2);
    const size_t hstepA = (size_t)HALF * lda * 2, hstepB = (size_t)HALF * K * 2;
    const size_t tstepA = 2 * hstepA, tstepB = 2 * hstepB;
    const unsigned ldsw = (unsigned)wid * 1024u;
    const int aoff = lds_byte(wr * 64 + fr, fq * 8), boff = lds_byte(wc * 32 + fr, fq * 8);
#define PG8_SA(b, h) (((b) * 2 + (h)) * HTB)
#define PG8_SB(b, h) ((4 + (b) * 2 + (h)) * HTB)
#define PG8_STAGE(bufoff, gbase, voff) do { _Pragma("unroll") for (int _i = 0; _i < 2; ++_i) \
        __builtin_amdgcn_global_load_lds((const unsigned*)((const char*)(gbase) + (voff)[_i]), (LAS unsigned*)(lds + (bufoff) + ldsw + _i * 8192), 16, 0, 0); } while (0)
#define PG8_LDA(dst, b, h) do { _Pragma("unroll") for (int m = 0; m < 4; ++m) _Pragma("unroll") for (int k = 0; k < 2; ++k) dst[m][k] = *(const LAS bf16x8*)(lds + PG8_SA(b, h) + aoff + m * 2048 + k * 1024); } while (0)
#define PG8_LDB(dst, b, h) do { _Pragma("unroll") for (int n = 0; n < 2; ++n) _Pragma("unroll") for (int k = 0; k < 2; ++k) dst[n][k] = *(const LAS bf16x8*)(lds + PG8_SB(b, h) + boff + n * 2048 + k * 1024); } while (0)
#define PG8_MMA(ai, bj, At, Bt) do { __builtin_amdgcn_s_setprio(1); _Pragma("unroll") for (int m = 0; m < 4; ++m) _Pragma("unroll") for (int n = 0; n < 2; ++n) _Pragma("unroll") for (int k = 0; k < 2; ++k) \
        acc[ai][bj][m][n] = __builtin_amdgcn_mfma_f32_16x16x32_bf16(Bt[n][k], At[m][k], acc[ai][bj][m][n], 0, 0, 0); __builtin_amdgcn_s_setprio(0); } while (0)
#define PG8_WAIT_V(n) asm volatile("s_waitcnt vmcnt(" #n ")" ::: "memory")
#define PG8_WAIT_L(n) asm volatile("s_waitcnt lgkmcnt(" #n ")" ::: "memory")
#define PG8_BAR __builtin_amdgcn_s_barrier()
#define PG8_SCHED __builtin_amdgcn_sched_barrier(0)
    Unit cur, nxt; int ui = 0;
    if (!S.next(0, cur)) return;
    f32x4 acc[2][2][4][2];
#pragma unroll
    for (int a = 0; a < 2; ++a)
#pragma unroll
        for (int b = 0; b < 2; ++b)
#pragma unroll
            for (int m = 0; m < 4; ++m)
#pragma unroll
                for (int n = 0; n < 2; ++n) acc[a][b][m][n] = (f32x4){0.f, 0.f, 0.f, 0.f};
    bf16x8 At[4][2], B0[2][2], B1[2][2];
    const char* cA = (const char*)g.A + (size_t)cur.pm * tstepA; const char* cB = (const char*)g.Bt + (size_t)cur.pn * tstepB;
    PG8_STAGE(PG8_SB(0, 0), cB, voffB); PG8_STAGE(PG8_SB(0, 1), cB + hstepB, voffB); PG8_STAGE(PG8_SA(0, 0), cA, voffA); PG8_STAGE(PG8_SA(0, 1), cA + hstepA, voffA);
    if (wr == 1) PG8_BAR;
    PG8_WAIT_V(2); PG8_BAR;
    PG8_STAGE(PG8_SB(1, 0), cB + kstep, voffB); PG8_STAGE(PG8_SA(1, 0), cA + kstep, voffA); PG8_STAGE(PG8_SB(1, 1), cB + hstepB + kstep, voffB);
    PG8_WAIT_V(6); PG8_BAR;
    for (;;) {
        const bool has_next = S.next(ui + 1, nxt);
        const char* nA = has_next ? (const char*)g.A + (size_t)nxt.pm * tstepA : cA; const char* nB = has_next ? (const char*)g.Bt + (size_t)nxt.pn * tstepB : cB;
        for (int t = 0; t < nt; t += 2) {
            const bool last = (t == nt - 2);
            const char* a1 = cA + (size_t)(t + 1) * kstep;
            const char* a2 = last ? nA : cA + (size_t)(t + 2) * kstep; const char* b2 = last ? nB : cB + (size_t)(t + 2) * kstep;
            const char* a3 = a2 + kstep; const char* b3 = b2 + kstep;
            PG8_LDB(B0, 0, 0); PG8_LDB(B1, 0, 1); PG8_SCHED; PG8_LDA(At, 0, 0); PG8_STAGE(PG8_SA(1, 1), a1 + hstepA, voffA);
            PG8_WAIT_V(8); PG8_WAIT_L(0); PG8_BAR; PG8_MMA(0, 0, At, B0); PG8_MMA(0, 1, At, B1); PG8_BAR; PG8_SCHED;
            PG8_LDA(At, 0, 1); PG8_STAGE(PG8_SB(0, 0), b2, voffB); PG8_STAGE(PG8_SB(0, 1), b2 + hstepB, voffB); PG8_STAGE(PG8_SA(0, 0), a2, voffA);
            PG8_WAIT_V(8); PG8_WAIT_L(0); PG8_BAR; PG8_MMA(1, 0, At, B0); PG8_MMA(1, 1, At, B1); PG8_BAR; PG8_SCHED;
            PG8_LDB(B0, 1, 0); PG8_LDB(B1, 1, 1); PG8_SCHED; PG8_LDA(At, 1, 0); PG8_STAGE(PG8_SA(0, 1), a2 + hstepA, voffA);
            PG8_WAIT_V(8); PG8_WAIT_L(0); PG8_BAR; PG8_MMA(0, 0, At, B0); PG8_MMA(0, 1, At, B1); PG8_BAR; PG8_SCHED;
            PG8_LDA(At, 1, 1); PG8_STAGE(PG8_SB(1, 0), b3, voffB); PG8_STAGE(PG8_SB(1, 1), b3 + hstepB, voffB); PG8_STAGE(PG8_SA(1, 0), a3, voffA);
            PG8_WAIT_V(8); PG8_WAIT_L(0); PG8_BAR; PG8_MMA(1, 0, At, B0); PG8_MMA(1, 1, At, B1); PG8_BAR; PG8_SCHED;
        }
        if constexpr (ALIGN_EPI) { if (wr == 0) PG8_BAR; }
        E(acc, cur, wr, wc, fr, fq);
        if (!has_next) break;
#pragma unroll
        for (int a = 0; a < 2; ++a)
#pragma unroll
            for (int b = 0; b < 2; ++b)
#pragma unroll
                for (int m = 0; m < 4; ++m)
#pragma unroll
                    for (int n = 0; n < 2; ++n) acc[a][b][m][n] = (f32x4){0.f, 0.f, 0.f, 0.f};
        cur = nxt; cA = nA; cB = nB; ++ui;
        if constexpr (ALIGN_EPI) { if (wr == 1) PG8_BAR; }
    }
    PG8_WAIT_V(0);
    if constexpr (!ALIGN_EPI) { if (wr == 0) PG8_BAR; }
    PG8_BAR;
#undef PG8_SA
#undef PG8_SB
#undef PG8_STAGE
#undef PG8_LDA
#undef PG8_LDB
#undef PG8_MMA
#undef PG8_WAIT_V
#undef PG8_WAIT_L
#undef PG8_BAR
#undef PG8_SCHED
}
}

typedef short s16x4 __attribute__((ext_vector_type(4)));
#define MFMA16(a, b, c) __builtin_amdgcn_mfma_f32_16x16x32_bf16((a), (b), (c), 0, 0, 0)
__device__ __forceinline__ s16x4 ld_tr4(const LAS bf16_t* p) { return __builtin_amdgcn_ds_read_tr16_b64_v4i16((LAS s16x4*)p); }
__device__ __forceinline__ bf16x8 cat8(s16x4 lo, s16x4 hi) { return __builtin_shufflevector(lo, hi, 0, 1, 2, 3, 4, 5, 6, 7); }
__device__ __forceinline__ bf16x8 frag_tr(const LAS bf16_t* img, int ld, int k0, int n0, int lane) {
    const int g = lane >> 4, i = lane & 15, q = i >> 2, p = i & 3;
    const LAS bf16_t* a = img + (k0 + 8 * g + q) * ld + n0 + 4 * p;
    return cat8(ld_tr4(a), ld_tr4(a + 4 * ld));
}
__device__ __forceinline__ bf16x8 frag_rm(const LAS bf16_t* img, int ld, int m0, int k0, int lane) {
    return *(const LAS bf16x8*)(img + (m0 + (lane & 15)) * ld + k0 + 8 * (lane >> 4));
}


#define XB_TMO      128
#define XB_XCNT(j)  (256  + 64 * (j))
#define XB_XSUB(j)  (1280 + 64 * (j))
#define XB_XGEN(j)  (2304 + 64 * (j))
#define XB_TOP      3328
#define XB_TOPGEN   3392
#define XCD_BAR_WORDS 3456
#define XB_SPIN_CAP (1u << 18)
__device__ __forceinline__ unsigned xb_ld(unsigned* p)              { return __hip_atomic_load(p, __ATOMIC_RELAXED, __HIP_MEMORY_SCOPE_AGENT); }
__device__ __forceinline__ unsigned xb_add(unsigned* p, unsigned v) { return __hip_atomic_fetch_add(p, v, __ATOMIC_RELAXED, __HIP_MEMORY_SCOPE_AGENT); }
__device__ __forceinline__ unsigned xb_xcc_id() { return (unsigned)__builtin_amdgcn_s_getreg((3 << 11) | 20) & 0xFu; }
#define XB_SPIN(cond, bar) do { unsigned _sp = 0; while (cond) { __builtin_amdgcn_s_sleep(1); \
    if ((++_sp & 255u) == 0u) { if (xb_ld(&(bar)[XB_TMO])) break; if (_sp > XB_SPIN_CAP) { atomicAdd(&(bar)[XB_TMO], 1u); break; } } } } while (0)
struct XcdBarrier { unsigned* bar; unsigned x; volatile LAS unsigned* st; };
__device__ __forceinline__ XcdBarrier xcd_barrier_post(unsigned* bar, volatile LAS unsigned* st) {
    XcdBarrier b; b.bar = bar; b.x = xb_xcc_id(); b.st = st;
    if (threadIdx.x == 0) (void)xb_add(&bar[XB_XCNT(b.x)], 1u);
    return b;
}
__device__ __forceinline__ void xcd_barrier_complete(unsigned* bar, unsigned x, unsigned& nloc, unsigned& nx) {
    const unsigned G = gridDim.x * gridDim.y * gridDim.z;
    unsigned sum, cnt, mine, sp = 0u;
    for (;;) {
        sum = 0u; cnt = 0u; mine = 0u;
#pragma unroll
        for (unsigned j = 0; j < 16; ++j) { const unsigned c = xb_ld(&bar[XB_XCNT(j)]); sum += c; cnt += (c > 0u) ? 1u : 0u; mine = (j == x) ? c : mine; }
        if (sum == G) break;
        __builtin_amdgcn_s_sleep(1);
        if ((++sp & 255u) == 0u) { if (xb_ld(&bar[XB_TMO])) break; if (sp > XB_SPIN_CAP) { atomicAdd(&bar[XB_TMO], 1u); break; } }
    }
    nloc = mine > 0u ? mine : 1u; nx = cnt > 0u ? cnt : 1u;
}
__device__ __forceinline__ void xcd_barrier(const XcdBarrier& b) {
    asm volatile("s_waitcnt vmcnt(0)" ::: "memory");
    __syncthreads();
    if (threadIdx.x == 0) {
        unsigned* bar = b.bar;
        __builtin_amdgcn_s_waitcnt(0);
        unsigned nloc = b.st[0], nx = b.st[1];
        if (nloc == 0u) { xcd_barrier_complete(bar, b.x, nloc, nx); b.st[0] = nloc; b.st[1] = nx; }
        const unsigned old = xb_add(&bar[XB_XSUB(b.x)], 1u);
        const unsigned gen = old / nloc;
        if (old + 1u == (gen + 1u) * nloc) {
            __builtin_amdgcn_fence(__ATOMIC_RELEASE, "agent");
            asm volatile("s_waitcnt vmcnt(0)" ::: "memory");
            const unsigned og = xb_add(&bar[XB_TOP], 1u);
            const unsigned tg = og / nx;
            if (og + 1u == (tg + 1u) * nx) xb_add(&bar[XB_TOPGEN], 1u);
            else XB_SPIN(xb_ld(&bar[XB_TOPGEN]) == tg, bar);
            __builtin_amdgcn_fence(__ATOMIC_ACQUIRE, "agent");
            xb_add(&bar[XB_XGEN(b.x)], 1u);
            asm volatile("s_waitcnt vmcnt(0)" ::: "memory");
        } else {
            XB_SPIN(xb_ld(&bar[XB_XGEN(b.x)]) == gen, bar);
            __builtin_amdgcn_fence(__ATOMIC_ACQUIRE, "agent");
            asm volatile("s_waitcnt vmcnt(0)" ::: "memory");
        }
    }
    __syncthreads();
}

struct Args {
    const float* in[25]; float* out; unsigned char* ws;
};

__device__ __forceinline__ void transpose_item(const float* W, int ldw, int K, const float* scale, bf16_t* WT, int k0, int n0, int c0, LAS float* scr, int lane) {
#pragma unroll 8
    for (int i = 0; i < 32; ++i) { const int kk = 2 * i + (lane >> 5); float w = W[(size_t)(k0 + kk) * ldw + c0 + (lane & 31)]; if (scale) w *= scale[k0 + kk]; scr[kk * 33 + (lane & 31)] = w; }
    asm volatile("s_waitcnt lgkmcnt(0)" ::: "memory");
    const int c = lane & 7;
#pragma unroll
    for (int j = 0; j < 4; ++j) { const int n = (lane >> 3) + 8 * j; const LAS float* s = scr + (8 * c) * 33 + n;
        u32x4 o; o.x = pk2(s[0 * 33], s[1 * 33]); o.y = pk2(s[2 * 33], s[3 * 33]); o.z = pk2(s[4 * 33], s[5 * 33]); o.w = pk2(s[6 * 33], s[7 * 33]);
        *(u32x4*)(WT + (size_t)(n0 + n) * K + k0 + 8 * c) = o; }
    asm volatile("s_waitcnt lgkmcnt(0)" ::: "memory");
}
__device__ __forceinline__ int colmap0(int n) {
    if (n < 2048) return n;
    if (n < 3072) return 3080 + (n - 2048);
    if (n < 4096) return 2048 + (n - 3072);
    if (n < 5120) return 5128 + (n - 4096);
    return 4104 + (n - 5120);
}
__device__ __forceinline__ void convert_weight(const float* W, int ldw, int K, int N, const float* scale, int mode, bf16_t* WT, LAS float* scr, int gw, int ngw, int lane) {
    const int nblk = N / 32, nitems = (K / 64) * nblk;
    for (int it = gw; it < nitems; it += ngw) {
        const int kb = it / nblk, nb = it % nblk, n0 = nb * 32;
        transpose_item(W, ldw, K, scale, WT, kb * 64, n0, mode ? colmap0(n0) : n0, scr, lane);
    }
}

template <int NC>
__device__ __forceinline__ void rows_prep(const float* X, const float* g, const float* W, int ldw, int col0, const float* bias_a, const float* bias_b,
                                          bf16_t* HN, float* rowsq, float* G, LAS float* sW, int gw, int ngw, int lane) {
#pragma unroll 4
    for (int i = threadIdx.x; i < 1024 * NC; i += NTHREADS) { const int k = i / NC, c = i % NC; sW[c * 1024 + k] = g[k] * W[(size_t)k * ldw + col0 + c]; }
    __syncthreads();
#pragma unroll 1
    for (int row = gw; row < M_; row += ngw) {
        const float* xr = X + (size_t)row * DM;
        float ss = 0.f;
        f32x4 xv[4];
#pragma unroll
        for (int j = 0; j < 4; ++j) xv[j] = *(const f32x4*)(xr + j * 256 + lane * 4);
#pragma unroll
        for (int j = 0; j < 4; ++j) {
            const f32x4 v = xv[j];
            ss += v[0] * v[0] + v[1] * v[1] + v[2] * v[2] + v[3] * v[3];
            u32x2 o; o.x = pk2(v[0], v[1]); o.y = pk2(v[2], v[3]);
            *(u32x2*)(HN + (size_t)row * DM + j * 256 + lane * 4) = o;
        }
        ss = wave_sum(ss);
        const float inv = rsqrtf(ss * (1.f / DM) + EPS);
        if (lane == 0) rowsq[row] = ss;
        float mine = 0.f;
#pragma unroll
        for (int c = 0; c < NC; ++c) {
            float dsum = 0.f;
#pragma unroll
            for (int j = 0; j < 4; ++j) { const f32x4 w4 = *(const LAS f32x4*)(sW + c * 1024 + j * 256 + lane * 4); dsum += (xv[j][0] * w4[0] + xv[j][1] * w4[1]) + (xv[j][2] * w4[2] + xv[j][3] * w4[3]); }
            dsum = wave_sum(dsum) * inv;
            if (bias_a) dsum += (c < NC / 2) ? bias_a[c] : bias_b[c - NC / 2];
            mine = (lane == c) ? dsum : mine;
            __builtin_amdgcn_sched_barrier(0);
        }
        if (lane < NC) G[(size_t)row * NC + lane] = mine;
    }
    __syncthreads();
}

__device__ __forceinline__ void mlstm_naive(bf16_t* P, const float* gif, const float* conv_w, const float* conv_b, const float* head_g, LAS float* sm, int item) {
    const int b = item >> 2, h = item & 3;
    const int tid = threadIdx.x, v = tid & 255, kq = tid >> 8;
    LAS float* sq = sm; LAS float* sk = sm + 128; LAS float* sred = sm + 256; LAS float* sden = sm + 768; LAS float* sss = sm + 772;
    float C[64];
#pragma unroll
    for (int j = 0; j < 64; ++j) C[j] = 0.f;
    float nst = 0.f, m = -1e30f;
    int ch = 0; float w0 = 0, w1 = 0, w2 = 0, w3 = 0, cb = 0, r0 = 0, r1 = 0, r2 = 0, hg = 0;
    if (tid < 256) {
        ch = (tid < 128) ? (h * 128 + tid) : (512 + h * 128 + (tid - 128));
        w0 = conv_w[0 * 1024 + ch]; w1 = conv_w[1 * 1024 + ch]; w2 = conv_w[2 * 1024 + ch]; w3 = conv_w[3 * 1024 + ch]; cb = conv_b[ch];
        hg = head_g[h * 256 + v];
    }
    const float qscale = 0.08838834764831845f;
    for (int t = 0; t < SEQ; ++t) {
        const size_t row = (size_t)b * SEQ + t;
        bf16_t* pr = P + row * NP;
        if (tid < 256) {
            const float raw = bf2f(pr[ch]);
            const float cv = w0 * r0 + w1 * r1 + w2 * r2 + w3 * raw + cb;
            r0 = r1; r1 = r2; r2 = raw;
            const float val = siluf_(cv);
            if (tid < 128) sq[tid] = val * qscale; else sk[tid - 128] = val;
        }
        const float ip = gif[row * 8 + h], fp = gif[row * 8 + 4 + h];
        const float logf = logsigmoidf_(fp);
        const float mn = fmaxf(logf + m, ip);
        const float fs = expf(logf + m - mn), is = expf(ip - mn);
        m = mn;
        const float vv = bf2f(pr[1024 + h * 256 + v]);
        __syncthreads();
        float part = 0.f;
#pragma unroll
        for (int j = 0; j < 64; ++j) { const int k = kq * 64 + j; C[j] = fs * C[j] + is * sk[k] * vv; part += C[j] * sq[k]; }
        sred[kq * 256 + v] = part;
        if (tid < 128) {
            nst = fs * nst + is * sk[tid];
            const float dp = wave_sum(nst * sq[tid]);
            if ((tid & 63) == 0) sden[tid >> 6] = dp;
        }
        __syncthreads();
        float val = 0.f;
        if (tid < 256) {
            const float num = sred[v] + sred[256 + v];
            const float den = sden[0] + sden[1];
            const float hv = num / fmaxf(fabsf(den), expf(-m));
            val = sigmoidf_(bf2f(pr[3072 + h * 256 + v])) * hv;
            const float s2 = wave_sum(val * val);
            if ((tid & 63) == 0) sss[tid >> 6] = s2;
        }
        __syncthreads();
        if (tid < 256) {
            const float inv = rsqrtf((sss[0] + sss[1] + sss[2] + sss[3]) * (1.f / 256.f) + EPS);
            pr[3072 + h * 256 + v] = f2bf(val * inv * hg * siluf_(bf2f(pr[5120 + h * 256 + v])));
        }
    }
    __syncthreads();
}


__device__ __forceinline__ float wave_scan_add(float v, int lane) {
#pragma unroll
    for (int o = 1; o < 64; o <<= 1) { const float y = __shfl_up(v, o); if (lane >= o) v += y; }
    return v;
}
__device__ __forceinline__ float wave_scan_max(float v, int lane) {
#pragma unroll
    for (int o = 1; o < 64; o <<= 1) { const float y = __shfl_up(v, o); if (lane >= o) v = fmaxf(v, y); }
    return v;
}
__device__ __forceinline__ float red16(float v) { v += __shfl_xor(v, 1); v += __shfl_xor(v, 2); v += __shfl_xor(v, 4); v += __shfl_xor(v, 8); return v; }
constexpr int ML_LDK = 136, ML_LDV = 264, ML_LDS = 72;

constexpr int ML_NSEG = 8, ML_SEGLEN = SEQ / ML_NSEG;
constexpr size_t SCR_XE = 0, SCR_CSEG = 4 * MiB, SCR_NSEG = 40 * MiB, SCR_SCAL = 41 * MiB;
__device__ __forceinline__ void mlstm_passA(const bf16_t* P, const float* gif, const float* conv_w, const float* conv_b, float* CSEG, float* NSEGN, float* SCAL, LAS unsigned char* lds, int item) {
    int tid_ = threadIdx.x; asm volatile("" : "+v"(tid_));
    const int tid0 = tid_, wave = __builtin_amdgcn_readfirstlane(tid0 >> 6);
    const int seg = item & 7, bh = item >> 3, b = bh >> 2, h = bh & 3;
    LAS bf16_t* Ks = (LAS bf16_t*)lds;
    LAS bf16_t* Vs = Ks + 64 * ML_LDK;
    LAS float* sw = (LAS float*)(Vs + 64 * ML_LDV);
    LAS float* sred = sw + 256;
    const size_t row0 = (size_t)b * SEQ + seg * ML_SEGLEN;
    {
        const int lane = tid0 & 63;
        float G = 0.f, ip = 0.f;
        if (tid0 < 256) { const float lf = logsigmoidf_(gif[(row0 + tid0) * 8 + 4 + h]); ip = gif[(row0 + tid0) * 8 + h]; G = wave_scan_add(lf, lane); if (lane == 63) sred[wave] = G; }
        __syncthreads();
        float a = -3.0e38f;
        const float Gtot = (sred[0] + sred[1]) + (sred[2] + sred[3]);
        if (tid0 < 256) { float off = 0.f; for (int w = 0; w < wave; ++w) off += sred[w]; G += off; a = Gtot - G + ip; }
        float mx = a;
#pragma unroll
        for (int o = 1; o < 64; o <<= 1) mx = fmaxf(mx, __shfl_xor(mx, o));
        if (lane == 0) sred[8 + wave] = mx;
        __syncthreads();
        const float mseg = fmaxf(fmaxf(sred[8], sred[9]), fmaxf(sred[10], sred[11]));
        if (tid0 < 256) sw[tid0] = __expf(a - mseg);
        if (tid0 == 0) { SCAL[item * 2] = Gtot; SCAL[item * 2 + 1] = mseg; }
    }
    f32x4 C[8][2];
#pragma unroll
    for (int i = 0; i < 8; ++i) { C[i][0] = (f32x4){0.f, 0.f, 0.f, 0.f}; C[i][1] = (f32x4){0.f, 0.f, 0.f, 0.f}; }
    float nacc = 0.f;
    const int ch = tid0 & 127, tq = tid0 >> 7, cch = 512 + h * 128 + ch;
    const float w0 = conv_w[cch], w1 = conv_w[1024 + cch], w2 = conv_w[2048 + cch], w3 = conv_w[3072 + cch], cb = conv_b[cch];
    __syncthreads();
    for (int c = 0; c < 4; ++c) {
        const int t0 = seg * ML_SEGLEN + c * 64;
        const size_t rowg = (size_t)b * SEQ + t0;
        {
            int tid = tid0; asm volatile("" : "+v"(tid));
            const int ts = tq * 16, tg = t0 + ts;
            const bf16_t* src = P + (rowg + ts) * NP + cch;
            float r0 = (tg >= 3) ? bf2f(src[-3 * NP]) : 0.f, r1 = (tg >= 2) ? bf2f(src[-2 * NP]) : 0.f, r2 = (tg >= 1) ? bf2f(src[-1 * NP]) : 0.f;
#pragma unroll 8
            for (int tt = 0; tt < 16; ++tt) {
                const float raw = bf2f(src[(size_t)tt * NP]);
                const float cv = w0 * r0 + w1 * r1 + w2 * r2 + w3 * raw + cb;
                r0 = r1; r1 = r2; r2 = raw;
                Ks[(ts + tt) * ML_LDK + ch] = f2bf(siluf_(cv) * sw[c * 64 + ts + tt]);
            }
#pragma unroll
            for (int j = 0; j < 4; ++j) { const int idx = tid + NTHREADS * j, row = idx >> 5, cc = idx & 31;
                *(LAS u32x4*)(Vs + row * ML_LDV + cc * 8) = *(const u32x4*)(P + (rowg + row) * NP + 1024 + h * 256 + cc * 8); }
        }
        __syncthreads();
        {
            int tid = tid0; asm volatile("" : "+v"(tid)); const int lane = tid & 63;
            if (tid < 128) {
#pragma unroll 8
                for (int srow = 0; srow < 64; ++srow) nacc += bf2f(Ks[srow * ML_LDK + tid]);
            }
#pragma unroll
            for (int ks = 0; ks < 2; ++ks) {
                const bf16x8 bv0 = frag_tr(Vs, ML_LDV, 32 * ks, 32 * wave, lane), bv1 = frag_tr(Vs, ML_LDV, 32 * ks, 32 * wave + 16, lane);
#pragma unroll
                for (int kt = 0; kt < 8; ++kt) { const bf16x8 af = frag_tr(Ks, ML_LDK, 32 * ks, 16 * kt, lane); C[kt][0] = MFMA16(af, bv0, C[kt][0]); C[kt][1] = MFMA16(af, bv1, C[kt][1]);
                    if (kt & 1) asm volatile("" ::: "memory"); }
            }
        }
        __syncthreads();
    }
    {
        int tid = tid0; asm volatile("" : "+v"(tid)); const int lane = tid & 63;
        float* cs = CSEG + ((size_t)item * 8 + wave) * 16 * 256 + lane * 4;
#pragma unroll
        for (int kt = 0; kt < 8; ++kt) { *(f32x4*)(cs + (kt * 2) * 256) = C[kt][0]; *(f32x4*)(cs + (kt * 2 + 1) * 256) = C[kt][1]; }
        if (tid < 128) NSEGN[(size_t)item * 128 + tid] = nacc;
    }
}

__device__ __forceinline__ void mlstm_passB(bf16_t* P, const float* gif, const float* conv_w, const float* conv_b, const float* head_g, const float* CSEG, const float* NSEGN, const float* SCAL, LAS unsigned char* lds, int item, int nseg) {
    int tid_ = threadIdx.x; asm volatile("" : "+v"(tid_));
    const int tid0 = tid_, wave = __builtin_amdgcn_readfirstlane(tid0 >> 6);
    const int seg = item % nseg, bh = item / nseg, b = bh >> 2, h = bh & 3, nchunk = 32 / nseg;
    LAS bf16_t* Qs = (LAS bf16_t*)lds;
    LAS bf16_t* Ks = Qs + 64 * ML_LDK;
    LAS bf16_t* Vs = Ks + 64 * ML_LDK;
    LAS bf16_t* SC = Vs + 64 * ML_LDV;
    LAS float* sE = (LAS float*)(SC + 64 * ML_LDS);
    LAS float* se = sE + 64; LAS float* sWi = se + 64; LAS float* sCl = sWi + 64; LAS float* sKw = sCl + 64; LAS float* sSc = sKw + 64;
    LAS float* denp = sSc + 4;
    LAS float* dnp = denp + 256;
    LAS float* ssq = dnp + 64;
    LAS float* sN = ssq + 512;
    f32x4 C[8][2];
#pragma unroll
    for (int i = 0; i < 8; ++i) { C[i][0] = (f32x4){0.f, 0.f, 0.f, 0.f}; C[i][1] = (f32x4){0.f, 0.f, 0.f, 0.f}; }
    float m_prev = -1e30f;
    if (seg == 0) { if (tid0 < 128) sN[tid0] = 0.f; }
    else {
        int tid = tid0; asm volatile("" : "+v"(tid)); const int lane = tid & 63;
        const float* sc0 = SCAL + (size_t)(item - seg) * 2;
        float total = 0.f, m0 = -3.0e38f;
#pragma unroll 1
        for (int q = 0; q < seg; ++q) total += sc0[2 * q];
        { float pre = 0.f;
#pragma unroll 1
          for (int q = 0; q < seg; ++q) { pre += sc0[2 * q]; m0 = fmaxf(m0, (total - pre) + sc0[2 * q + 1]); } }
        float nn = 0.f, pre = 0.f;
#pragma unroll 1
        for (int q = 0; q < seg; ++q) {
            pre += sc0[2 * q];
            const float cf = __expf((total - pre) + sc0[2 * q + 1] - m0);
            const float* cs = CSEG + ((size_t)(item - seg + q) * 8 + wave) * 16 * 256 + lane * 4;
#pragma unroll
            for (int kt = 0; kt < 8; ++kt) { C[kt][0] += cf * *(const f32x4*)(cs + (kt * 2) * 256); C[kt][1] += cf * *(const f32x4*)(cs + (kt * 2 + 1) * 256); }
            if (tid < 128) nn += cf * NSEGN[(size_t)(item - seg + q) * 128 + tid];
        }
        if (tid < 128) sN[tid] = nn;
        m_prev = m0;
    }
    const int ch = tid0 & 255, th = tid0 >> 8;
    const int cch = (ch < 128) ? (h * 128 + ch) : (512 + h * 128 + (ch - 128));
    const float w0 = conv_w[cch], w1 = conv_w[1024 + cch], w2 = conv_w[2048 + cch], w3 = conv_w[3072 + cch], cb = conv_b[cch];
    const float qscale = 0.08838834764831845f;
    for (int c = 0; c < nchunk; ++c) {
        const int t0 = seg * (SEQ / nseg) + c * 64;
        const size_t rowg = (size_t)b * SEQ + t0;
        {
        int tid = tid0; asm volatile("" : "+v"(tid)); const int lane = tid & 63, g4 = lane >> 4, l15 = lane & 15; (void)g4; (void)l15;
        {
            const int ts = th * 32;
            const bf16_t* src = P + (rowg + ts) * NP + cch;
            const int tg = t0 + ts;
            float r0 = (tg >= 3) ? bf2f(src[-3 * NP]) : 0.f, r1 = (tg >= 2) ? bf2f(src[-2 * NP]) : 0.f, r2 = (tg >= 1) ? bf2f(src[-1 * NP]) : 0.f;
            LAS bf16_t* dst = (ch < 128) ? (Qs + ts * ML_LDK + ch) : (Ks + ts * ML_LDK + (ch - 128));
            const float sc = (ch < 128) ? qscale : 1.f;
#pragma unroll 8
            for (int tt = 0; tt < 32; ++tt) {
                const float raw = bf2f(src[(size_t)tt * NP]);
                const float cv = w0 * r0 + w1 * r1 + w2 * r2 + w3 * raw + cb;
                r0 = r1; r1 = r2; r2 = raw;
                dst[tt * ML_LDK] = f2bf(siluf_(cv) * sc);
            }
        }
#pragma unroll
        for (int j = 0; j < 4; ++j) { const int idx = tid + NTHREADS * j, row = idx >> 5, cc = idx & 31;
            *(LAS u32x4*)(Vs + row * ML_LDV + cc * 8) = *(const u32x4*)(P + (rowg + row) * NP + 1024 + h * 256 + cc * 8); }
        if (wave == 0) {
            const float lf = logsigmoidf_(gif[(rowg + lane) * 8 + 4 + h]), ip = gif[(rowg + lane) * 8 + h];
            const float bc = wave_scan_add(lf, lane);
            const float e = ip - bc;
            const float E = fmaxf(wave_scan_max(e, lane), m_prev);
            const float E63 = __shfl(E, 63);
            sE[lane] = E; se[lane] = e; sWi[lane] = __expf(m_prev - E); sCl[lane] = __expf(-(bc + E)); sKw[lane] = __expf(e - E63);
            if (lane == 63) { sSc[0] = __expf(m_prev - E63); sSc[1] = bc + E63; }
        }
        }
        __syncthreads();
        {
        int tid = tid0; asm volatile("" : "+v"(tid)); const int lane = tid & 63, g4 = lane >> 4, l15 = lane & 15; (void)g4; (void)l15;
#pragma unroll
        for (int j = 0; j < 2; ++j) {
            const int mt = wave >> 1, nt = 2 * (wave & 1) + j;
            f32x4 acc = {0.f, 0.f, 0.f, 0.f};
#pragma unroll
            for (int ks = 0; ks < 4; ++ks) acc = MFMA16(frag_rm(Qs, ML_LDK, 16 * mt, 32 * ks, lane), frag_rm(Ks, ML_LDK, 16 * nt, 32 * ks, lane), acc);
            const int sidx = 16 * nt + l15; const float es = se[sidx];
#pragma unroll
            for (int r = 0; r < 4; ++r) {
                const int t = 16 * mt + 4 * g4 + r;
                const float wgt = (sidx <= t) ? __expf(es - sE[t]) : 0.f;
                const float val = wgt * acc[r];
                SC[t * ML_LDS + sidx] = f2bf(val);
                const float rs = red16(val);
                if (l15 == 0) denp[t * 4 + nt] = rs;
            }
        }
        {
            const int t = tid >> 3, pp = tid & 7;
            float part = 0.f;
#pragma unroll
            for (int k = 0; k < 16; ++k) part += bf2f(Qs[t * ML_LDK + pp * 16 + k]) * sN[pp * 16 + k];
            part += __shfl_xor(part, 1); part += __shfl_xor(part, 2); part += __shfl_xor(part, 4);
            if (pp == 0) dnp[t] = part;
        }
        }
        __syncthreads();
        f32x4 num[4][2];
        {
        int tid = tid0; asm volatile("" : "+v"(tid)); const int lane = tid & 63, g4 = lane >> 4, l15 = lane & 15; (void)g4; (void)l15;
#pragma unroll
        for (int mt = 0; mt < 4; ++mt) { num[mt][0] = (f32x4){0.f, 0.f, 0.f, 0.f}; num[mt][1] = (f32x4){0.f, 0.f, 0.f, 0.f}; }
#pragma unroll
        for (int ks = 0; ks < 4; ++ks) {
            bf16x8 sb[2];
#pragma unroll
            for (int nt = 0; nt < 2; ++nt) { u32x4 sw; sw.x = pk2(C[2 * ks][nt][0], C[2 * ks][nt][1]); sw.y = pk2(C[2 * ks][nt][2], C[2 * ks][nt][3]);
                sw.z = pk2(C[2 * ks + 1][nt][0], C[2 * ks + 1][nt][1]); sw.w = pk2(C[2 * ks + 1][nt][2], C[2 * ks + 1][nt][3]); sb[nt] = __builtin_bit_cast(bf16x8, sw); }
#pragma unroll
            for (int mt = 0; mt < 4; ++mt) {
                const LAS bf16_t* ap = Qs + (16 * mt + l15) * ML_LDK + 32 * ks + 4 * g4;
                const bf16x8 af = cat8(*(const LAS s16x4*)ap, *(const LAS s16x4*)(ap + 16));
                num[mt][0] = MFMA16(af, sb[0], num[mt][0]); num[mt][1] = MFMA16(af, sb[1], num[mt][1]);
                if (mt & 1) asm volatile("" ::: "memory");
            }
        }
#pragma unroll
        for (int mt = 0; mt < 4; ++mt)
#pragma unroll
            for (int r = 0; r < 4; ++r) { const float wi = sWi[16 * mt + 4 * g4 + r]; num[mt][0][r] *= wi; num[mt][1][r] *= wi; }
#pragma unroll
        for (int ks = 0; ks < 2; ++ks) {
            const bf16x8 bv0 = frag_tr(Vs, ML_LDV, 32 * ks, 32 * wave, lane), bv1 = frag_tr(Vs, ML_LDV, 32 * ks, 32 * wave + 16, lane);
#pragma unroll
            for (int mt = 0; mt < 4; ++mt) { const bf16x8 af = frag_rm(SC, ML_LDS, 16 * mt, 32 * ks, lane); num[mt][0] = MFMA16(af, bv0, num[mt][0]); num[mt][1] = MFMA16(af, bv1, num[mt][1]); }
            asm volatile("" ::: "memory");
        }
#pragma unroll
        for (int mt = 0; mt < 4; ++mt)
#pragma unroll
            for (int r = 0; r < 4; ++r) {
                const int t = 16 * mt + 4 * g4 + r;
                const float den = (denp[t * 4] + denp[t * 4 + 1]) + (denp[t * 4 + 2] + denp[t * 4 + 3]) + sWi[t] * dnp[t];
                const float dd = 1.f / fmaxf(fabsf(den), sCl[t]);
                num[mt][0][r] *= dd; num[mt][1][r] *= dd;
            }
        }
        {
        int tid = tid0; asm volatile("" : "+v"(tid)); const int lane = tid & 63, g4 = lane >> 4, l15 = lane & 15; (void)g4; (void)l15;
#pragma unroll
        for (int j = 0; j < 8; ++j) { const int idx = tid + NTHREADS * j, srow = idx >> 6, kp = idx & 63;
            LAS unsigned* wp = (LAS unsigned*)(Ks + srow * ML_LDK + 2 * kp); const unsigned wv = *wp; const float kwt = sKw[srow];
            *wp = pk2(bflo(wv) * kwt, bfhi(wv) * kwt); }
        }
        const float cs = sSc[0], m_new = sSc[1];
        __syncthreads();
        {
        int tid = tid0; asm volatile("" : "+v"(tid)); const int lane = tid & 63, g4 = lane >> 4, l15 = lane & 15; (void)g4; (void)l15;
        if (tid < 128) { float an = cs * sN[tid];
#pragma unroll 8
            for (int srow = 0; srow < 64; ++srow) an += bf2f(Ks[srow * ML_LDK + tid]);
            sN[tid] = an; }
#pragma unroll
        for (int i = 0; i < 8; ++i) { C[i][0] = C[i][0] * cs; C[i][1] = C[i][1] * cs; }
#pragma unroll
        for (int ks = 0; ks < 2; ++ks) {
            const bf16x8 bv0 = frag_tr(Vs, ML_LDV, 32 * ks, 32 * wave, lane), bv1 = frag_tr(Vs, ML_LDV, 32 * ks, 32 * wave + 16, lane);
#pragma unroll
            for (int kt = 0; kt < 8; ++kt) { const bf16x8 af = frag_tr(Ks, ML_LDK, 32 * ks, 16 * kt, lane); C[kt][0] = MFMA16(af, bv0, C[kt][0]); C[kt][1] = MFMA16(af, bv1, C[kt][1]);
                if (kt & 1) asm volatile("" ::: "memory"); }
        }
        }
        __syncthreads();
        {
        int tid = tid0; asm volatile("" : "+v"(tid)); const int lane = tid & 63, g4 = lane >> 4, l15 = lane & 15; (void)g4; (void)l15;
#pragma unroll
        for (int mt = 0; mt < 4; ++mt)
#pragma unroll
            for (int r = 0; r < 4; ++r) { LAS bf16_t* hp = Vs + (16 * mt + 4 * g4 + r) * ML_LDV + 32 * wave + l15; hp[0] = f2bf(num[mt][0][r]); hp[16] = f2bf(num[mt][1][r]); }
        }
        __syncthreads();
        {
            int tid = tid0; asm volatile("" : "+v"(tid)); const int lane = tid & 63, g4 = lane >> 4, l15 = lane & 15; (void)g4; (void)l15;
            const int t = tid >> 3, pp = tid & 7;
            bf16_t* pr = P + (rowg + t) * NP + h * 256 + pp * 32;
            float val[32]; float q2 = 0.f;
#pragma unroll
            for (int j = 0; j < 4; ++j) {
                const u32x4 hv = *(const LAS u32x4*)(Vs + t * ML_LDV + pp * 32 + 8 * j);
                const u32x4 ov = *(const u32x4*)(pr + 3072 + 8 * j);
                const unsigned hw[4] = {hv.x, hv.y, hv.z, hv.w}, ow[4] = {ov.x, ov.y, ov.z, ov.w};
#pragma unroll
                for (int e = 0; e < 4; ++e) { const float a0 = sigmoidf_(bflo(ow[e])) * bflo(hw[e]), a1 = sigmoidf_(bfhi(ow[e])) * bfhi(hw[e]);
                    val[8 * j + 2 * e] = a0; val[8 * j + 2 * e + 1] = a1; q2 += a0 * a0 + a1 * a1; }
            }
            q2 += __shfl_xor(q2, 1); q2 += __shfl_xor(q2, 2); q2 += __shfl_xor(q2, 4);
            const float inv = rsqrtf(q2 * (1.f / 256.f) + EPS);
#pragma unroll
            for (int j = 0; j < 4; ++j) {
                const u32x4 zv = *(const u32x4*)(pr + 5120 + 8 * j);
                const f32x4 ga = *(const f32x4*)(head_g + h * 256 + pp * 32 + 8 * j), gb = *(const f32x4*)(head_g + h * 256 + pp * 32 + 8 * j + 4);
                const unsigned zw[4] = {zv.x, zv.y, zv.z, zv.w};
                float o8[8];
#pragma unroll
                for (int e = 0; e < 4; ++e) {
                    const float g0 = (e < 2) ? ga[2 * e] : gb[2 * e - 4], g1 = (e < 2) ? ga[2 * e + 1] : gb[2 * e - 3];
                    o8[2 * e] = val[8 * j + 2 * e] * inv * g0 * siluf_(bflo(zw[e]));
                    o8[2 * e + 1] = val[8 * j + 2 * e + 1] * inv * g1 * siluf_(bfhi(zw[e]));
                }
                u32x4 w; w.x = pk2(o8[0], o8[1]); w.y = pk2(o8[2], o8[3]); w.z = pk2(o8[4], o8[5]); w.w = pk2(o8[6], o8[7]);
                *(u32x4*)(pr + 3072 + 8 * j) = w;
            }
        }
        m_prev = m_new;
        __syncthreads();
    }
}


typedef float f32x16 __attribute__((ext_vector_type(16)));
#define MFMA32(a, b, c) __builtin_amdgcn_mfma_f32_32x32x16_bf16((a), (b), (c), 0, 0, 0)
constexpr int S5_SEGS = 8, S5_SEGLEN = SEQ / S5_SEGS, S5_LD = 168, S5_IMG_BYTES = 2 * 16 * S5_LD * 2;
struct S5Lane { float ar[2], ai[2]; bf16x8 bt[4]; };
__device__ __forceinline__ void s5_lane_consts(S5Lane& L, const float* lam_re, const float* lam_im, const float* log_dt, const float* b_re, const float* b_im, int g, int n, int hh) {
    const float dt = expf(log_dt[g]);
#pragma unroll
    for (int pi = 0; pi < 2; ++pi) {
        const int p = n + 32 * pi;
        const float lr = lam_re[g * 64 + p], li = lam_im[g * 64 + p];
        const float ex = expf(lr * dt), cs = cosf(li * dt), sn = sinf(li * dt);
        const float ar = ex * cs, ai = ex * sn, s2 = sinf(0.5f * li * dt);
        const float a1r = expm1f(lr * dt) * cs - 2.f * s2 * s2, a1i = ai, den = lr * lr + li * li;
        const float qr = (a1r * lr + a1i * li) / den, qi = (a1i * lr - a1r * li) / den;
        L.ar[pi] = ar; L.ai[pi] = ai;
        const f32x4 br0 = *(const f32x4*)(b_re + (size_t)(g * 64 + p) * 16 + 8 * hh), br1 = *(const f32x4*)(b_re + (size_t)(g * 64 + p) * 16 + 8 * hh + 4);
        const f32x4 bi0 = *(const f32x4*)(b_im + (size_t)(g * 64 + p) * 16 + 8 * hh), bi1 = *(const f32x4*)(b_im + (size_t)(g * 64 + p) * 16 + 8 * hh + 4);
        u32x4 wre, wim;
        wre.x = pk2(br0[0] * qr - bi0[0] * qi, br0[1] * qr - bi0[1] * qi); wre.y = pk2(br0[2] * qr - bi0[2] * qi, br0[3] * qr - bi0[3] * qi);
        wre.z = pk2(br1[0] * qr - bi1[0] * qi, br1[1] * qr - bi1[1] * qi); wre.w = pk2(br1[2] * qr - bi1[2] * qi, br1[3] * qr - bi1[3] * qi);
        wim.x = pk2(br0[0] * qi + bi0[0] * qr, br0[1] * qi + bi0[1] * qr); wim.y = pk2(br0[2] * qi + bi0[2] * qr, br0[3] * qi + bi0[3] * qr);
        wim.z = pk2(br1[0] * qi + bi1[0] * qr, br1[1] * qi + bi1[1] * qr); wim.w = pk2(br1[2] * qi + bi1[2] * qr, br1[3] * qi + bi1[3] * qr);
        L.bt[pi] = __builtin_bit_cast(bf16x8, wre); L.bt[2 + pi] = __builtin_bit_cast(bf16x8, wim);
    }
}
__device__ __forceinline__ const bf16_t* s5_urow(const bf16_t* P, int bp, int g, int t0, int lane) {
    const int m = lane & 31, hh = lane >> 5, sq = (m >> 2) & 1, tok = (m >> 3) * 4 + (m & 3);
    return P + ((size_t)(2 * bp + sq) * SEQ + t0 + tok) * NP + 2048 + g * 16 + 8 * hh;
}
__device__ __forceinline__ void s5_passA(const bf16_t* P, const float* lam_re, const float* lam_im, const float* log_dt, const float* b_re, const float* b_im, float* XE, int item, int lane) {
    const int seg = item & 7, g = (item >> 3) & 63, bp = item >> 9, n = lane & 31, hh = lane >> 5;
    S5Lane L; s5_lane_consts(L, lam_re, lam_im, log_dt, b_re, b_im, g, n, hh);
    float x0r = 0.f, x0i = 0.f, x1r = 0.f, x1i = 0.f;
    const f32x16 zero = {0.f, 0.f, 0.f, 0.f, 0.f, 0.f, 0.f, 0.f, 0.f, 0.f, 0.f, 0.f, 0.f, 0.f, 0.f, 0.f};
    const bf16_t* up = s5_urow(P, bp, g, seg * S5_SEGLEN, lane);
    bf16x8 af = *(const bf16x8*)up;
    for (int blk = 0; blk < S5_SEGLEN / 16; ++blk) {
        const bf16x8 cur = af;
        if (blk + 1 < S5_SEGLEN / 16) af = *(const bf16x8*)(up + (size_t)(blk + 1) * 16 * NP);
        const f32x16 d0 = MFMA32(cur, L.bt[0], zero), d1 = MFMA32(cur, L.bt[1], zero), d2 = MFMA32(cur, L.bt[2], zero), d3 = MFMA32(cur, L.bt[3], zero);
#pragma unroll
        for (int r = 0; r < 16; ++r) {
            const float n0r = L.ar[0] * x0r - L.ai[0] * x0i + d0[r], n0i = L.ar[0] * x0i + L.ai[0] * x0r + d2[r];
            const float n1r = L.ar[1] * x1r - L.ai[1] * x1i + d1[r], n1i = L.ar[1] * x1i + L.ai[1] * x1r + d3[r];
            x0r = n0r; x0i = n0i; x1r = n1r; x1i = n1i;
        }
    }
    *(f32x4*)(XE + ((size_t)item * 64 + lane) * 4) = (f32x4){x0r, x0i, x1r, x1i};
}
__device__ __forceinline__ void s5_passB(bf16_t* P, const float* lam_re, const float* lam_im, const float* log_dt, const float* b_re, const float* b_im,
                                         const float* c_re, const float* c_im, const float* dskip, const float* XE, LAS bf16_t* img, int item, int lane) {
    const int seg = item & 7, g = (item >> 3) & 63, bp = item >> 9, n = lane & 31, hh = lane >> 5, l15 = lane & 15, g4 = lane >> 4;
    S5Lane L; s5_lane_consts(L, lam_re, lam_im, log_dt, b_re, b_im, g, n, hh);
    bf16x8 ct[5];
#pragma unroll
    for (int ks = 0; ks < 4; ++ks) {
        const int p0 = 8 * ks + 2 * g4;
        const float* cr = c_re + (size_t)(g * 16 + l15) * 64; const float* ci = c_im + (size_t)(g * 16 + l15) * 64;
        u32x4 w;
        w.x = pk2(cr[p0], cr[32 + p0]); w.y = pk2(-ci[p0], -ci[32 + p0]); w.z = pk2(cr[p0 + 1], cr[32 + p0 + 1]); w.w = pk2(-ci[p0 + 1], -ci[32 + p0 + 1]);
        ct[ks] = __builtin_bit_cast(bf16x8, w);
    }
    {
        const float dv = dskip[g * 16 + l15];
        u32x4 w = {0u, 0u, 0u, 0u};
        const int kq = l15 - 8 * g4;
        const unsigned dbits = (unsigned)f2bf(dv);
        if (g4 < 2 && kq >= 0 && kq < 8) { const unsigned val = (kq & 1) ? (dbits << 16) : dbits; if ((kq >> 1) == 0) w.x = val; else if ((kq >> 1) == 1) w.y = val; else if ((kq >> 1) == 2) w.z = val; else w.w = val; }
        ct[4] = __builtin_bit_cast(bf16x8, w);
    }
    float x0r = 0.f, x0i = 0.f, x1r = 0.f, x1i = 0.f;
    {
        float p0r = L.ar[0], p0i = L.ai[0], p1r = L.ar[1], p1i = L.ai[1];
#pragma unroll
        for (int q = 0; q < 8; ++q) { const float t0r = p0r * p0r - p0i * p0i, t0i = 2.f * p0r * p0i, t1r = p1r * p1r - p1i * p1i, t1i = 2.f * p1r * p1i; p0r = t0r; p0i = t0i; p1r = t1r; p1i = t1i; }
        for (int sp = 0; sp < seg; ++sp) {
            const f32x4 xe = *(const f32x4*)(XE + ((size_t)(item - seg + sp) * 64 + lane) * 4);
            const float n0r = p0r * x0r - p0i * x0i + xe[0], n0i = p0r * x0i + p0i * x0r + xe[1];
            const float n1r = p1r * x1r - p1i * x1i + xe[2], n1i = p1r * x1i + p1i * x1r + xe[3];
            x0r = n0r; x0i = n0i; x1r = n1r; x1i = n1i;
        }
    }
    { const int row = lane >> 1, hf = lane & 1; if (row < 32) *(LAS u32x4*)(img + row * S5_LD + 144 + 8 * hf) = (u32x4){0u, 0u, 0u, 0u}; }
    const f32x16 zero = {0.f, 0.f, 0.f, 0.f, 0.f, 0.f, 0.f, 0.f, 0.f, 0.f, 0.f, 0.f, 0.f, 0.f, 0.f, 0.f};
    const bf16_t* up = s5_urow(P, bp, g, seg * S5_SEGLEN, lane);
    const int m = lane & 31, usq = (m >> 2) & 1, utok = (m >> 3) * 4 + (m & 3);
    bf16x8 af = *(const bf16x8*)up;
    for (int blk = 0; blk < S5_SEGLEN / 16; ++blk) {
        const bf16x8 cur = af;
        if (blk + 1 < S5_SEGLEN / 16) af = *(const bf16x8*)(up + (size_t)(blk + 1) * 16 * NP);
        *(LAS bf16x8*)(img + (usq * 16 + utok) * S5_LD + 128 + 8 * hh) = cur;
        const f32x16 d0 = MFMA32(cur, L.bt[0], zero), d1 = MFMA32(cur, L.bt[1], zero), d2 = MFMA32(cur, L.bt[2], zero), d3 = MFMA32(cur, L.bt[3], zero);
#pragma unroll
        for (int r = 0; r < 16; ++r) {
            const float n0r = L.ar[0] * x0r - L.ai[0] * x0i + d0[r], n0i = L.ar[0] * x0i + L.ai[0] * x0r + d2[r];
            const float n1r = L.ar[1] * x1r - L.ai[1] * x1i + d1[r], n1i = L.ar[1] * x1i + L.ai[1] * x1r + d3[r];
            x0r = n0r; x0i = n0i; x1r = n1r; x1i = n1i;
            u32x2 w; w.x = pk2(x0r, x1r); w.y = pk2(x0i, x1i);
            *(LAS u32x2*)(img + (hh * 16 + r) * S5_LD + 4 * n) = w;
        }
        asm volatile("s_waitcnt lgkmcnt(0)" ::: "memory");
#pragma unroll
        for (int sq = 0; sq < 2; ++sq) {
            f32x4 y = {0.f, 0.f, 0.f, 0.f};
#pragma unroll
            for (int ks = 0; ks < 5; ++ks) y = MFMA16(frag_rm(img + sq * 16 * S5_LD, S5_LD, 0, 32 * ks, lane), ct[ks], y);
            bf16_t* op = P + ((size_t)(2 * bp + sq) * SEQ + seg * S5_SEGLEN + blk * 16 + 4 * g4) * NP + 2048 + g * 16 + l15;
#pragma unroll
            for (int r = 0; r < 4; ++r) {
                const float v = y[r], uu = 0.7978845608028654f * (v + 0.044715f * v * v * v);
                const float th = 1.f - 2.f / (__expf(2.f * uu) + 1.f);
                op[(size_t)r * NP] = f2bf(0.5f * v * (1.f + th));
            }
        }
        asm volatile("s_waitcnt lgkmcnt(0)" ::: "memory");
    }
}

__device__ __forceinline__ void s5_naive(bf16_t* P, const float* lam_re, const float* lam_im, const float* log_dt, const float* b_re, const float* b_im,
                                         const float* c_re, const float* c_im, const float* dskip, int item, int p) {
    const int b = item >> 6, g = item & 63;
    const float lr = lam_re[g * 64 + p], li = lam_im[g * 64 + p], dt = expf(log_dt[g]);
    const float ex = expf(lr * dt), cs = cosf(li * dt), sn = sinf(li * dt);
    const float ar = ex * cs, ai = ex * sn;
    const float s2 = sinf(0.5f * li * dt);
    const float a1r = expm1f(lr * dt) * cs - 2.f * s2 * s2, a1i = ai;
    const float den = lr * lr + li * li;
    const float qr = (a1r * lr + a1i * li) / den, qi = (a1i * lr - a1r * li) / den;
    float bbr[16], bbi[16], cr[16], ci[16];
#pragma unroll
    for (int c = 0; c < 16; ++c) {
        const float br = b_re[(size_t)(g * 64 + p) * 16 + c], bi = b_im[(size_t)(g * 64 + p) * 16 + c];
        bbr[c] = br * qr - bi * qi; bbi[c] = br * qi + bi * qr;
        cr[c] = c_re[(size_t)(g * 16 + c) * 64 + p]; ci[c] = c_im[(size_t)(g * 16 + c) * 64 + p];
    }
    const float dd = dskip[g * 16 + (p & 15)];
    float xr = 0.f, xi = 0.f;
    for (int t = 0; t < SEQ; ++t) {
        bf16_t* pu = P + ((size_t)b * SEQ + t) * NP + 2048 + g * 16;
        float u[16];
#pragma unroll
        for (int c = 0; c < 16; ++c) u[c] = bf2f(pu[c]);
        const float up = bf2f(pu[p & 15]);
        float bur = 0.f, bui = 0.f;
#pragma unroll
        for (int c = 0; c < 16; ++c) { bur += bbr[c] * u[c]; bui += bbi[c] * u[c]; }
        const float nxr = ar * xr - ai * xi + bur, nxi = ar * xi + ai * xr + bui;
        xr = nxr; xi = nxi;
        float my = 0.f;
#pragma unroll
        for (int c = 0; c < 16; ++c) { const float yc = wave_sum(cr[c] * xr - ci[c] * xi); my = (p == c) ? yc : my; }
        if (p < 16) pu[p] = f2bf(gelu_tanh(my + dd * up));
    }
}

__device__ __forceinline__ void gla_naive(bf16_t* P, const float* R, const float* w_alpha, const float* b_alpha, LAS float* sm, int item) {
    const int b = item >> 3, h = (item >> 1) & 3, half = item & 1;
    const int tid = threadIdx.x, v = tid & 255, kh = tid >> 8;
    LAS float* sq = sm; LAS float* sk = sm + 256; LAS float* sa = sm + 512; LAS float* sred = sm + 768;
    float S[128];
#pragma unroll
    for (int j = 0; j < 128; ++j) S[j] = 0.f;
    float wa[16], ba = 0.f;
#pragma unroll
    for (int j = 0; j < 16; ++j) wa[j] = 0.f;
    if (tid < 256) {
#pragma unroll
        for (int j = 0; j < 16; ++j) wa[j] = w_alpha[j * 1024 + h * 256 + tid];
        ba = b_alpha[h * 256 + tid];
    }
    for (int t = 0; t < SEQ; ++t) {
        const size_t row = (size_t)b * SEQ + t;
        bf16_t* pr = P + row * NP;
        if (tid < 256) {
            const int kk = h * 256 + tid;
            float x = ba;
#pragma unroll
            for (int j = 0; j < 16; ++j) x += R[row * 16 + j] * wa[j];
            sa[tid] = expf(logsigmoidf_(x) * (1.f / 16.f));
            sq[tid] = bf2f(pr[kk]) * (1.f / 16.f);
            sk[tid] = bf2f(pr[1024 + kk]);
        }
        const int vc = 2048 + h * 512 + half * 256 + v;
        const float vv = bf2f(pr[vc]);
        __syncthreads();
        float part = 0.f;
#pragma unroll
        for (int j = 0; j < 128; ++j) { const int k = kh * 128 + j; S[j] = sa[k] * S[j] + sk[k] * vv; part += sq[k] * S[j]; }
        sred[kh * 256 + v] = part;
        __syncthreads();
        if (tid < 256) pr[vc] = f2bf(sred[v] + sred[256 + v]);
    }
    __syncthreads();
}


constexpr int GL_LDQ = 264, GL_LDA = 72;
__device__ __forceinline__ void gla_prep(bf16_t* P, const float* R, const float* w_alpha, const float* b_alpha, bf16_t* ATT, float* EG, LAS unsigned char* lds, int bx, int G) {
    int tid_ = threadIdx.x; asm volatile("" : "+v"(tid_));
    const int tid = tid_, lane = tid & 63, wave = __builtin_amdgcn_readfirstlane(tid >> 6);
    LAS bf16_t* Qs = (LAS bf16_t*)lds;
    LAS bf16_t* Ks = Qs + 64 * GL_LDQ;
    LAS float* sR = (LAS float*)(lds + 2 * 64 * GL_LDQ * 2);
    LAS float* tot = sR + 1024;
    const int kk = tid & 255, half = tid >> 8;
    for (int item = bx; item < 1024; item += G) {
        const int h = item & 3, bc = item >> 2;
        const size_t row0 = (size_t)bc * 64;
        for (int i = tid; i < 1024; i += NTHREADS) sR[i] = R[row0 * 16 + i];
        float wa[16];
#pragma unroll
        for (int j = 0; j < 16; ++j) wa[j] = w_alpha[j * 1024 + h * 256 + kk];
        const float ba = b_alpha[h * 256 + kk];
        __syncthreads();
        float cum[32]; float run = 0.f;
#pragma unroll
        for (int tt = 0; tt < 32; ++tt) {
            const int t = half * 32 + tt;
            float x = ba;
#pragma unroll
            for (int j = 0; j < 16; ++j) x += sR[t * 16 + j] * wa[j];
            run += logsigmoidf_(x) * (1.f / 16.f);
            cum[tt] = run;
        }
        tot[half * 256 + kk] = run;
        __syncthreads();
        const float off = half ? tot[kk] : 0.f;
        const float gsum = tot[kk] + tot[256 + kk];
#pragma unroll
        for (int tt = 0; tt < 32; ++tt) {
            const int t = half * 32 + tt;
            const float c = cum[tt] + off;
            bf16_t* pr = P + (row0 + t) * NP + h * 256 + kk;
            const float qv = bf2f(pr[0]), kv = bf2f(pr[1024]);
            const bf16_t qb = f2bf(qv * __expf(c) * (1.f / 16.f));
            Qs[t * GL_LDQ + kk] = qb; pr[0] = qb;
            Ks[t * GL_LDQ + kk] = f2bf(kv * __expf(-c));
            pr[1024] = f2bf(kv * __expf(gsum - c));
        }
        if (half == 0) EG[(size_t)item * 256 + kk] = __expf(gsum);
        __syncthreads();
#pragma unroll
        for (int j = 0; j < 2; ++j) {
            const int mt = wave >> 1, nt = 2 * (wave & 1) + j;
            f32x4 acc = {0.f, 0.f, 0.f, 0.f};
#pragma unroll
            for (int ks = 0; ks < 8; ++ks) acc = MFMA16(frag_rm(Qs, GL_LDQ, 16 * mt, 32 * ks, lane), frag_rm(Ks, GL_LDQ, 16 * nt, 32 * ks, lane), acc);
            const int sc = 16 * nt + (lane & 15);
#pragma unroll
            for (int r = 0; r < 4; ++r) { const int t = 16 * mt + 4 * (lane >> 4) + r; ATT[(size_t)item * 4096 + t * 64 + sc] = f2bf(sc <= t ? acc[r] : 0.f); }
        }
        __syncthreads();
    }
}

__device__ __forceinline__ void gla_scan(bf16_t* P, const bf16_t* ATT, const float* EG, LAS unsigned char* lds, int bx) {
    int tid_ = threadIdx.x; asm volatile("" : "+v"(tid_));
    const int tid = tid_, lane = tid & 63, wave = __builtin_amdgcn_readfirstlane(tid >> 6), kg = wave >> 2, vq = wave & 3, g4 = lane >> 4, l15 = lane & 15;
    const int bh = 4 * (bx & 7) + (bx >> 6), vs = (bx >> 3) & 7, b = bh >> 2, h = bh & 3;
    LAS bf16_t* Qt = (LAS bf16_t*)lds;
    LAS bf16_t* Ke = Qt + 64 * GL_LDQ;
    LAS bf16_t* At = Ke + 64 * GL_LDQ;
    LAS bf16_t* Vs = At + 64 * GL_LDA;
    LAS float* eg = (LAS float*)(Vs + 64 * GL_LDA);
    LAS float* part = eg + 256;
    f32x4 S[8];
#pragma unroll
    for (int i = 0; i < 8; ++i) S[i] = (f32x4){0.f, 0.f, 0.f, 0.f};
    u32x4 pq[4], pk[4], pa, pv; f32x4 pe = {0.f, 0.f, 0.f, 0.f};
    const int prow = tid >> 5, pcc = tid & 31;
    const int arow = tid >> 3, acc8 = tid & 7;
#define GL_LOAD(c) do { const size_t rowg = (size_t)b * SEQ + (size_t)(c) * 64; const size_t item = ((size_t)b * 32 + (c)) * 4 + h; \
        _Pragma("unroll") for (int j = 0; j < 4; ++j) { const bf16_t* src = P + (rowg + prow + 16 * j) * NP + h * 256 + pcc * 8; pq[j] = *(const u32x4*)src; pk[j] = *(const u32x4*)(src + 1024); } \
        pa = *(const u32x4*)(ATT + item * 4096 + arow * 64 + acc8 * 8); \
        pv = *(const u32x4*)(P + (rowg + arow) * NP + 2048 + h * 512 + vs * 64 + acc8 * 8); \
        if (tid < 64) pe = *(const f32x4*)(EG + item * 256 + tid * 4); } while (0)
    GL_LOAD(0);
    for (int c = 0; c < 32; ++c) {
#pragma unroll
        for (int j = 0; j < 4; ++j) { *(LAS u32x4*)(Qt + (prow + 16 * j) * GL_LDQ + pcc * 8) = pq[j]; *(LAS u32x4*)(Ke + (prow + 16 * j) * GL_LDQ + pcc * 8) = pk[j]; }
        *(LAS u32x4*)(At + arow * GL_LDA + acc8 * 8) = pa;
        *(LAS u32x4*)(Vs + arow * GL_LDA + acc8 * 8) = pv;
        if (tid < 64) *(LAS f32x4*)(eg + tid * 4) = pe;
        __syncthreads();
        if (c + 1 < 32) GL_LOAD(c + 1);
        f32x4 o[4];
#pragma unroll
        for (int mt = 0; mt < 4; ++mt) o[mt] = (f32x4){0.f, 0.f, 0.f, 0.f};
#pragma unroll
        for (int ks = 0; ks < 4; ++ks) {
            u32x4 sw; sw.x = pk2(S[2 * ks][0], S[2 * ks][1]); sw.y = pk2(S[2 * ks][2], S[2 * ks][3]); sw.z = pk2(S[2 * ks + 1][0], S[2 * ks + 1][1]); sw.w = pk2(S[2 * ks + 1][2], S[2 * ks + 1][3]);
            const bf16x8 sb = __builtin_bit_cast(bf16x8, sw);
#pragma unroll
            for (int mt = 0; mt < 4; ++mt) {
                const LAS bf16_t* ap = Qt + (16 * mt + l15) * GL_LDQ + 128 * kg + 32 * ks + 4 * g4;
                const s16x4 lo = *(const LAS s16x4*)ap, hi = *(const LAS s16x4*)(ap + 16);
                o[mt] = MFMA16(cat8(lo, hi), sb, o[mt]);
            }
        }
        const bf16x8 bv0 = frag_tr(Vs, GL_LDA, 0, 16 * vq, lane), bv1 = frag_tr(Vs, GL_LDA, 32, 16 * vq, lane);
        const bf16x8 bvm = kg ? bv1 : bv0;
#pragma unroll
        for (int mt = 0; mt < 4; ++mt) o[mt] = MFMA16(frag_rm(At, GL_LDA, 16 * mt, 32 * kg, lane), bvm, o[mt]);
        if (kg == 1) {
#pragma unroll
            for (int mt = 0; mt < 4; ++mt)
#pragma unroll
                for (int r = 0; r < 4; ++r) part[(vq * 64 + 16 * mt + 4 * g4 + r) * 16 + l15] = o[mt][r];
        }
        __syncthreads();
        if (kg == 0) {
            const size_t rowg = (size_t)b * SEQ + (size_t)c * 64;
#pragma unroll
            for (int mt = 0; mt < 4; ++mt)
#pragma unroll
                for (int r = 0; r < 4; ++r) {
                    const int t = 16 * mt + 4 * g4 + r;
                    P[(rowg + t) * NP + 2048 + h * 512 + vs * 64 + 16 * vq + l15] = f2bf(o[mt][r] + part[(vq * 64 + t) * 16 + l15]);
                }
        }
#pragma unroll
        for (int i = 0; i < 8; ++i) {
            const int k0 = 128 * kg + 16 * i;
            const f32x4 e4 = *(const LAS f32x4*)(eg + k0 + 4 * g4);
            S[i] = S[i] * e4;
            S[i] = MFMA16(frag_tr(Ke, GL_LDQ, 0, k0, lane), bv0, S[i]);
            S[i] = MFMA16(frag_tr(Ke, GL_LDQ, 32, k0, lane), bv1, S[i]);
        }
        __syncthreads();
    }
#undef GL_LOAD
}

__device__ __forceinline__ void headnorm1(bf16_t* P, const float* head_g, int gw, int ngw, int lane) {
    for (int item = gw; item < M_ * 4; item += ngw) {
        const int row = item >> 2, h = item & 3;
        bf16_t* pr = P + (size_t)row * NP;
        const u32x4 ov = *(const u32x4*)(pr + 2048 + h * 512 + lane * 8);
        const u32x4 zv = *(const u32x4*)(pr + 4096 + h * 512 + lane * 8);
        const unsigned ow[4] = {ov.x, ov.y, ov.z, ov.w}, zw[4] = {zv.x, zv.y, zv.z, zv.w};
        float val[8]; float ss = 0.f;
#pragma unroll
        for (int e = 0; e < 4; ++e) { val[2 * e] = bflo(ow[e]); val[2 * e + 1] = bfhi(ow[e]); ss += val[2 * e] * val[2 * e] + val[2 * e + 1] * val[2 * e + 1]; }
        ss = wave_sum(ss);
        const float inv = rsqrtf(ss * (1.f / 512.f) + EPS);
        const f32x4 g0 = *(const f32x4*)(head_g + h * 512 + lane * 8), g1 = *(const f32x4*)(head_g + h * 512 + lane * 8 + 4);
        float o[8];
#pragma unroll
        for (int e = 0; e < 4; ++e) {
            const float ga = (e < 2) ? g0[2 * e] : g1[2 * e - 4], gb = (e < 2) ? g0[2 * e + 1] : g1[2 * e - 3];
            o[2 * e] = val[2 * e] * inv * ga * siluf_(bflo(zw[e]));
            o[2 * e + 1] = val[2 * e + 1] * inv * gb * siluf_(bfhi(zw[e]));
        }
        u32x4 w; w.x = pk2(o[0], o[1]); w.y = pk2(o[2], o[3]); w.z = pk2(o[4], o[5]); w.w = pk2(o[6], o[7]);
        *(u32x4*)(pr + 4096 + h * 512 + lane * 8) = w;
    }
}

__device__ __forceinline__ void final_norm(float* X, const float* g, int gw, int ngw, int lane) {
    for (int row = gw; row < M_; row += ngw) {
        float* xr = X + (size_t)row * DM;
        f32x4 v[4]; float ss = 0.f;
#pragma unroll
        for (int j = 0; j < 4; ++j) { v[j] = *(const f32x4*)(xr + j * 256 + lane * 4); ss += v[j][0] * v[j][0] + v[j][1] * v[j][1] + v[j][2] * v[j][2] + v[j][3] * v[j][3]; }
        ss = wave_sum(ss);
        const float inv = rsqrtf(ss * (1.f / DM) + EPS);
#pragma unroll
        for (int j = 0; j < 4; ++j) { const f32x4 gg = *(const f32x4*)(g + j * 256 + lane * 4); *(f32x4*)(xr + j * 256 + lane * 4) = v[j] * inv * gg; }
    }
}

__global__ void __launch_bounds__(NTHREADS, 2) mega_fwd(Args a) {
    extern __shared__ __attribute__((aligned(16))) unsigned char lds_raw[];
    LAS unsigned char* lds = (LAS unsigned char*)lds_raw;
    volatile LAS unsigned* MISC = (volatile LAS unsigned*)(lds + RING_BYTES);
    if (threadIdx.x < 64) MISC[threadIdx.x] = 0u;
    __syncthreads();
    const XcdBarrier gbar = xcd_barrier_post((unsigned*)a.ws, MISC + 8);
    const int wave = __builtin_amdgcn_readfirstlane(threadIdx.x >> 6);
#define FRESH_LANE ({ int l_ = threadIdx.x & 63; asm volatile("" : "+v"(l_)); l_; })
    const int G = gridDim.x, bx = blockIdx.x;
    const int gw = bx * NWAVES + wave, ngw = G * NWAVES;
    unsigned char* ws = a.ws;
    bf16_t* WIN = (bf16_t*)(ws + WS_WIN); bf16_t* WGLU = (bf16_t*)(ws + WS_WGLU); bf16_t* WOUT0 = (bf16_t*)(ws + WS_WOUT0); bf16_t* WOUT1 = (bf16_t*)(ws + WS_WOUT1);
    bf16_t* HN = (bf16_t*)(ws + WS_HN); bf16_t* P = (bf16_t*)(ws + WS_P);
    bf16_t* ATT = (bf16_t*)(ws + WS_HN); float* EGB = (float*)(ws + WS_HN + 8 * MiB);
    float* GIF = (float*)(ws + WS_GIF); float* R = (float*)(ws + WS_R); float* RSQ0 = (float*)(ws + WS_RSQ0); float* RSQ1 = (float*)(ws + WS_RSQ1);
    const float* x = a.in[0]; const float* norm_g = a.in[1]; float* out = a.out;
    float* XE = (float*)((unsigned char*)a.out + SCR_XE);
    float* CSEG = (float*)((unsigned char*)a.out + SCR_CSEG); float* NSEGN = (float*)((unsigned char*)a.out + SCR_NSEG); float* SCAL = (float*)((unsigned char*)a.out + SCR_SCAL);
    LAS float* scr = (LAS float*)(lds + wave * 16384);

    convert_weight(a.in[3], 6152, 1024, 6144, norm_g, 1, WIN, scr, gw, ngw, FRESH_LANE);
    convert_weight(a.in[17], 1024, 1024, 1024, nullptr, 0, WGLU, scr, gw, ngw, FRESH_LANE);
    convert_weight(a.in[19], 1024, 2048, 1024, nullptr, 0, WOUT0, scr, gw, ngw, FRESH_LANE);
    convert_weight(a.in[24], 1024, 2048, 1024, nullptr, 0, WOUT1, scr, gw, ngw, FRESH_LANE);
    __syncthreads();
    rows_prep<8>(x, norm_g, a.in[3], 6152, 3072, a.in[6], a.in[7], HN, RSQ0, GIF, (LAS float*)lds, gw, ngw, FRESH_LANE);
    xcd_barrier(gbar);
    { pg8::Gemm g{HN, DM, WIN, M_, 6144, 1024}; pg8::StaticOrder S; S.init(M_, 6144, G, bx); pg8::EpiProj E{P, RSQ0}; pg8::gemm_phase<pg8::EpiProj>(lds, g, S, E); }
    xcd_barrier(gbar);
    mlstm_passA(P, GIF, a.in[4], a.in[5], CSEG, NSEGN, SCAL, lds, bx);
    for (int it = gw; it < 2048; it += ngw) s5_passA(P, a.in[9], a.in[10], a.in[11], a.in[12], a.in[13], XE, it, FRESH_LANE);
    convert_weight(a.in[20], 6160, 1024, 6144, norm_g + 1024, 0, WIN, scr, gw, ngw, FRESH_LANE);
    xcd_barrier(gbar);
    mlstm_passB(P, GIF, a.in[4], a.in[5], a.in[8], CSEG, NSEGN, SCAL, lds, bx, ML_NSEG);
    { LAS bf16_t* img = (LAS bf16_t*)(lds + wave * S5_IMG_BYTES);
      for (int it = gw; it < 2048; it += ngw) s5_passB(P, a.in[9], a.in[10], a.in[11], a.in[12], a.in[13], a.in[14], a.in[15], a.in[16], XE, img, it, FRESH_LANE); }
    xcd_barrier(gbar);
    { pg8::Gemm g{P + 2048, NP, WGLU, M_, 1024, 1024}; pg8::StaticOrder S; S.init(M_, 1024, G, bx); pg8::EpiGlu E{P, a.in[18]}; pg8::gemm_phase<pg8::EpiGlu>(lds, g, S, E); }
    xcd_barrier(gbar);
    { pg8::Gemm g{P + 3072, NP, WOUT0, M_, 1024, 2048}; pg8::StaticOrder S; S.init(M_, 1024, G, bx); pg8::EpiRes E{x, out}; pg8::gemm_phase<pg8::EpiRes>(lds, g, S, E); }
    xcd_barrier(gbar);
    rows_prep<16>(out, norm_g + 1024, a.in[20], 6160, 6144, nullptr, nullptr, HN, RSQ1, R, (LAS float*)lds, gw, ngw, FRESH_LANE);
    xcd_barrier(gbar);
    { pg8::Gemm g{HN, DM, WIN, M_, 6144, 1024}; pg8::StaticOrder S; S.init(M_, 6144, G, bx); pg8::EpiProj E{P, RSQ1}; pg8::gemm_phase<pg8::EpiProj>(lds, g, S, E); }
    xcd_barrier(gbar);
    gla_prep(P, R, a.in[21], a.in[22], ATT, EGB, lds, bx, G);
    xcd_barrier(gbar);
    gla_scan(P, ATT, EGB, lds, bx);
    xcd_barrier(gbar);
    headnorm1(P, a.in[23], gw, ngw, FRESH_LANE);
    xcd_barrier(gbar);
    { pg8::Gemm g{P + 4096, NP, WOUT1, M_, 1024, 2048}; pg8::StaticOrder S; S.init(M_, 1024, G, bx); pg8::EpiRes E{out, out}; pg8::gemm_phase<pg8::EpiRes>(lds, g, S, E); }
    xcd_barrier(gbar);
    final_norm(out, a.in[2], gw, ngw, FRESH_LANE);
}

extern "C" void kernel_launch(void* const* d_in, const int* in_sizes, int n_in, void* d_out, int out_size, void* d_ws, size_t ws_size, hipStream_t stream) {
    static int grid = 0;
    if (grid == 0) {
        int dev = 0, cus = 0, per_cu = 0;
        hipGetDevice(&dev);
        hipDeviceGetAttribute(&cus, hipDeviceAttributeMultiprocessorCount, dev);
        hipFuncSetAttribute((const void*)mega_fwd, hipFuncAttributeMaxDynamicSharedMemorySize, LDS_BYTES);
        hipOccupancyMaxActiveBlocksPerMultiprocessor(&per_cu, (const void*)mega_fwd, NTHREADS, LDS_BYTES);
        if (per_cu < 1) { fprintf(stderr, "kernel_launch: occupancy query reports %d blocks/CU\n", per_cu); per_cu = 1; }
        grid = cus;
        (void)hipGetLastError();
    }
    (void)hipMemsetAsync(d_ws, 0, 16384, stream);
    Args a{};
    for (int i = 0; i < 25; ++i) a.in[i] = (const float*)d_in[i];
    a.out = (float*)d_out; a.ws = (unsigned char*)d_ws;
    void* args[] = {&a};
    hipError_t e = hipLaunchCooperativeKernel((const void*)mega_fwd, dim3(grid), dim3(NTHREADS), args, LDS_BYTES, stream);
    if (e != hipSuccess) fprintf(stderr, "cooperative launch failed: %s (grid %d)\n", hipGetErrorString(e), grid);
}
```

```cpp
#include <hip/hip_runtime.h>
#include <cstdio>
#include <cstdint>

typedef unsigned short bf16_t;
#define LAS __attribute__((address_space(3)))
typedef short bf16x8 __attribute__((ext_vector_type(8)));
typedef float f32x4 __attribute__((ext_vector_type(4)));
typedef float f32x2 __attribute__((ext_vector_type(2)));
typedef unsigned u32x4 __attribute__((ext_vector_type(4)));
typedef unsigned u32x2 __attribute__((ext_vector_type(2)));

constexpr int BATCH = 8, SEQ = 2048, DM = 1024, M_ = BATCH * SEQ;
constexpr int NP = 6144;
constexpr float EPS = 1e-6f;
constexpr int NWAVES = 8, NTHREADS = 512;

constexpr size_t MiB = 1u << 20;
constexpr size_t WS_WIN = 1 * MiB;
constexpr size_t WS_WGLU = 13 * MiB;
constexpr size_t WS_WOUT0 = 15 * MiB;
constexpr size_t WS_WOUT1 = 19 * MiB;
constexpr size_t WS_HN = 23 * MiB;
constexpr size_t WS_P = 55 * MiB;
constexpr size_t WS_GIF = 247 * MiB;
constexpr size_t WS_R = 248 * MiB;
constexpr size_t WS_RSQ0 = 249 * MiB;
constexpr size_t WS_RSQ1 = 249 * MiB + 65536;

constexpr int RING_BYTES = 131072;
constexpr int LDS_BYTES = 139264;
constexpr int RTAB_OFF = RING_BYTES + 2048;

__device__ __forceinline__ float bf2f(bf16_t v) { return __uint_as_float(((unsigned)v) << 16); }
typedef __bf16 bf16v2 __attribute__((ext_vector_type(2)));
__device__ __forceinline__ unsigned pk2(float lo, float hi) { const f32x2 v = {lo, hi}; return __builtin_bit_cast(unsigned, __builtin_convertvector(v, bf16v2)); }
__device__ __forceinline__ bf16_t f2bf(float f) { return (bf16_t)(pk2(f, 0.f) & 0xffffu); }
__device__ __forceinline__ float sigmoidf_(float x) { return __builtin_amdgcn_rcpf(1.f + __expf(-x)); }
__device__ __forceinline__ float siluf_(float x) { return x * sigmoidf_(x); }
__device__ __forceinline__ float logsigmoidf_(float x) { return fminf(x, 0.f) - __logf(1.f + __expf(-fabsf(x))); }
__device__ __forceinline__ float gelu_tanh(float x) { const float c = 0.7978845608028654f; float u = c * (x + 0.044715f * x * x * x); return 0.5f * x * (1.f + tanhf(u)); }
__device__ __forceinline__ float wave_sum(float v) {
#pragma unroll
    for (int o = 1; o < 64; o <<= 1) v += __shfl_xor(v, o);
    return v;
}
__device__ __forceinline__ int lane_id() { int l; asm volatile("v_mbcnt_lo_u32_b32 %0, -1, 0\n\tv_mbcnt_hi_u32_b32 %0, -1, %0" : "=v"(l)); return l; }
__device__ __forceinline__ float bflo(unsigned w) { return __uint_as_float(w << 16); }
__device__ __forceinline__ float bfhi(unsigned w) { return __uint_as_float(w & 0xffff0000u); }

namespace pg8 {
constexpr int BM = 256, BK = 64, HALF = 128, HTB = HALF * BK * 2, STAGE_BYTES = 8 * HTB, NXCD = 8, WGM = 8;
__host__ __device__ __forceinline__ int lds_byte(int r, int c) { const int st = (r >> 4) * 2 + (c >> 5), rr = r & 15, cc = c & 31, ob = rr * 64 + cc * 2; return st * 1024 + (ob ^ (((ob >> 9) & 1) << 5)); }
__host__ __device__ __forceinline__ void stage_rc(int b, int& R, int& C) { const int st = b / 1024, sb = b % 1024, swz = sb ^ (((sb >> 9) & 1) << 5); R = (st >> 1) * 16 + swz / 64; C = (st & 1) * 32 + (swz % 64) / 2; }
__host__ __device__ __forceinline__ int perm32(int rho) { const int n = rho >> 4, i = rho & 15; return 8 * (i >> 2) + 4 * n + (i & 3); }

struct Unit { int pm, pn; };
struct Gemm { const bf16_t* A; int lda; const bf16_t* Bt; int M, N, K; };

struct StaticOrder {
    int nM, nN, nwg, G, c;
    __host__ __device__ void init(int M, int N, int G_, int c_) { nM = M / BM; nN = N / BM; nwg = nM * nN; G = G_; c = c_; }
    __host__ __device__ bool next(int i, Unit& u) const {
        const long L = (long)i * G + c; if (L >= nwg) return false;
        int wgid = (int)L; { const int q = nwg / NXCD, r = nwg % NXCD, xcd = wgid % NXCD, off = wgid / NXCD; wgid = (xcd < r ? xcd * (q + 1) : r * (q + 1) + (xcd - r) * q) + off; }
        const int nig = WGM * nN, gid = wgid / nig, fm = gid * WGM, gsz = (nM - fm) < WGM ? (nM - fm) : WGM;
        u.pm = fm + ((wgid % nig) % gsz); u.pn = (wgid % nig) / gsz; return true;
    }
};

struct EpiProj {
    static constexpr bool PERM = true, HSCALE = false;
    bf16_t* P; const float* rowsq;
    __device__ __forceinline__ void operator()(const f32x4 (&acc)[2][2][4][2], const Unit& u, int wr, int wc, int fr, int fq) const {
        const int row0 = u.pm * BM + wr * 64 + fr, col0 = u.pn * BM + wc * 32 + 8 * fq;
#pragma unroll
        for (int ai = 0; ai < 2; ++ai)
#pragma unroll
            for (int m = 0; m < 4; ++m) {
                const int row = row0 + ai * HALF + m * 16;
                const float inv = rsqrtf(rowsq[row] * (1.f / DM) + EPS);
                bf16_t* rowp = P + (size_t)row * NP + col0;
#pragma unroll
                for (int bj = 0; bj < 2; ++bj) {
                    const f32x4 v0 = acc[ai][bj][m][0] * inv, v1 = acc[ai][bj][m][1] * inv;
                    u32x4 w; w.x = pk2(v0[0], v0[1]); w.y = pk2(v0[2], v0[3]); w.z = pk2(v1[0], v1[1]); w.w = pk2(v1[2], v1[3]);
                    *(u32x4*)(rowp + bj * HALF) = w;
                }
            }
    }
};
struct EpiGlu {
    static constexpr bool PERM = true, HSCALE = false;
    bf16_t* P; const float* bias;
    __device__ __forceinline__ void operator()(const f32x4 (&acc)[2][2][4][2], const Unit& u, int wr, int wc, int fr, int fq) const {
        const int row0 = u.pm * BM + wr * 64 + fr, col0 = u.pn * BM + wc * 32 + 8 * fq;
        f32x4 bv[2][2];
#pragma unroll
        for (int bj = 0; bj < 2; ++bj)
#pragma unroll
            for (int n = 0; n < 2; ++n) bv[bj][n] = *(const f32x4*)(bias + col0 + bj * HALF + 4 * n);
#pragma unroll
        for (int ai = 0; ai < 2; ++ai)
#pragma unroll
            for (int m = 0; m < 4; ++m) {
                const int row = row0 + ai * HALF + m * 16;
                bf16_t* rowp = P + (size_t)row * NP + col0;
#pragma unroll
                for (int bj = 0; bj < 2; ++bj) {
                    const u32x4 yg = *(const u32x4*)(rowp + 2048 + bj * HALF);
                    const u32x4 zb = *(const u32x4*)(rowp + 4096 + bj * HALF);
                    const f32x4 s0 = acc[ai][bj][m][0] + bv[bj][0], s1 = acc[ai][bj][m][1] + bv[bj][1];
                    float o[8];
                    const unsigned yw[4] = {yg.x, yg.y, yg.z, yg.w}, zw[4] = {zb.x, zb.y, zb.z, zb.w};
#pragma unroll
                    for (int e = 0; e < 4; ++e) {
                        const float sa = (e < 2) ? s0[2 * e] : s1[2 * e - 4], sb = (e < 2) ? s0[2 * e + 1] : s1[2 * e - 3];
                        o[2 * e] = bflo(yw[e]) * sigmoidf_(sa) * siluf_(bflo(zw[e]));
                        o[2 * e + 1] = bfhi(yw[e]) * sigmoidf_(sb) * siluf_(bfhi(zw[e]));
                    }
                    u32x4 w; w.x = pk2(o[0], o[1]); w.y = pk2(o[2], o[3]); w.z = pk2(o[4], o[5]); w.w = pk2(o[6], o[7]);
                    *(u32x4*)(rowp + 4096 + bj * HALF) = w;
                }
            }
    }
};
struct EpiRes {
    static constexpr bool PERM = false, HSCALE = false;
    const float* X; float* O;
    __device__ __forceinline__ void operator()(const f32x4 (&acc)[2][2][4][2], const Unit& u, int wr, int wc, int fr, int fq) const {
        const int row0 = u.pm * BM + wr * 64 + fr, col0 = u.pn * BM + wc * 32 + 4 * fq;
#pragma unroll
        for (int ai = 0; ai < 2; ++ai)
#pragma unroll
            for (int m = 0; m < 4; ++m) {
                const size_t off = (size_t)(row0 + ai * HALF + m * 16) * DM + col0;
#pragma unroll
                for (int bj = 0; bj < 2; ++bj)
#pragma unroll
                    for (int n = 0; n < 2; ++n) {
                        const f32x4 xv = *(const f32x4*)(X + off + bj * HALF + n * 16);
                        *(f32x4*)(O + off + bj * HALF + n * 16) = xv + acc[ai][bj][m][n];
                    }
            }
    }
};

struct EpiResHN {
    static constexpr bool PERM = false, HSCALE = false;
    const float* X; float* O; bf16_t* HN; float* rsq;
    __device__ __forceinline__ void operator()(const f32x4 (&acc)[2][2][4][2], const Unit& u, int wr, int wc, int fr, int fq) const {
        const int row0 = u.pm * BM + wr * 64 + fr, col0 = u.pn * BM + wc * 32 + 4 * fq;
#pragma unroll
        for (int ai = 0; ai < 2; ++ai)
#pragma unroll
            for (int m = 0; m < 4; ++m) {
                const int row = row0 + ai * HALF + m * 16;
                const size_t off = (size_t)row * DM + col0;
                float ssq = 0.f;
#pragma unroll
                for (int bj = 0; bj < 2; ++bj)
#pragma unroll
                    for (int n = 0; n < 2; ++n) {
                        const f32x4 xv = *(const f32x4*)(X + off + bj * HALF + n * 16);
                        const f32x4 o = xv + acc[ai][bj][m][n];
                        *(f32x4*)(O + off + bj * HALF + n * 16) = o;
                        u32x2 w; w.x = pk2(o[0], o[1]); w.y = pk2(o[2], o[3]);
                        *(u32x2*)(HN + off + bj * HALF + n * 16) = w;
                        ssq += (o[0] * o[0] + o[1] * o[1]) + (o[2] * o[2] + o[3] * o[3]);
                    }
                ssq += __shfl_xor(ssq, 16); ssq += __shfl_xor(ssq, 32);
                if (fq == 0) atomicAdd(rsq + row, ssq);
            }
    }
};

struct EpiResH {
    static constexpr bool PERM = false, HSCALE = true;
    const float* X; float* O; const float* ssq;
    __device__ __forceinline__ void operator()(const f32x4 (&acc)[2][2][4][2], const Unit& u, int wr, int wc, int fr, int fq, const LAS float* rtab) const {
        const int row0 = u.pm * BM + wr * 64 + fr, col0 = u.pn * BM + wc * 32 + 4 * fq;
#pragma unroll
        for (int ai = 0; ai < 2; ++ai)
#pragma unroll
            for (int m = 0; m < 4; ++m) {
                const size_t off = (size_t)(row0 + ai * HALF + m * 16) * DM + col0;
                const float sc = rtab[(ai * HALF + wr * 64 + m * 16 + fr) * 4 + 3];
#pragma unroll
                for (int bj = 0; bj < 2; ++bj)
#pragma unroll
                    for (int n = 0; n < 2; ++n) {
                        const f32x4 xv = *(const f32x4*)(X + off + bj * HALF + n * 16);
                        *(f32x4*)(O + off + bj * HALF + n * 16) = xv + acc[ai][bj][m][n] * sc;
                    }
            }
    }
};

template <class Epi, bool ALIGN_EPI = true>
__device__ __forceinline__ void gemm_phase(LAS unsigned char* lds, const Gemm g, const StaticOrder& S, const Epi& E, int wv) {
    int tid_ = wv * 64 + lane_id(); asm volatile("" : "+v"(tid_));
    const int tid = tid_, wid = __builtin_amdgcn_readfirstlane(tid >> 6), lane = tid & 63, wr = wid >> 2, wc = wid & 3, fr = lane & 15, fq = lane >> 4;
    const int K = g.K, nt = K / BK, lda = g.lda;
    unsigned voffA[2], voffB[2];
#pragma unroll
    for (int i = 0; i < 2; ++i) { int R, C; stage_rc(tid * 16 + i * 8192, R, C); const int Rb = Epi::PERM ? ((R & ~31) + perm32(R & 31)) : R;
        voffA[i] = (unsigned)(R * lda + C) * 2u; voffB[i] = (unsigned)(Rb * K + C) * 2u; }
    const size_t kstep = (size_t)(BK * 2);
    const size_t hstepA = (size_t)HALF * lda * 2, hstepB = (size_t)HALF * K * 2;
    const size_t tstepA = 2 * hstepA, tstepB = 2 * hstepB;
    const unsigned ldsw = (unsigned)wid * 1024u;
    const int aoff = lds_byte(wr * 64 + fr, fq * 8), boff = lds_byte(wc * 32 + fr, fq * 8);
#define PG8_SA(b, h) (((b) * 2 + (h)) * HTB)
#define PG8_SB(b, h) ((4 + (b) * 2 + (h)) * HTB)
#define PG8_STAGE(bufoff, gbase, voff) do { _Pragma("unroll") for (int _i = 0; _i < 2; ++_i) \
        __builtin_amdgcn_global_load_lds((const unsigned*)((const char*)(gbase) + (voff)[_i]), (LAS unsigned*)(lds + (bufoff) + ldsw + _i * 8192), 16, 0, 0); } while (0)
#define PG8_LDA(dst, b, h) do { _Pragma("unroll") for (int m = 0; m < 4; ++m) _Pragma("unroll") for (int k = 0; k < 2; ++k) dst[m][k] = *(const LAS bf16x8*)(lds + PG8_SA(b, h) + aoff + m * 2048 + k * 1024); } while (0)
#define PG8_LDB(dst, b, h) do { _Pragma("unroll") for (int n = 0; n < 2; ++n) _Pragma("unroll") for (int k = 0; k < 2; ++k) dst[n][k] = *(const LAS bf16x8*)(lds + PG8_SB(b, h) + boff + n * 2048 + k * 1024); } while (0)
#define PG8_MMA(ai, bj, At, Bt) do { __builtin_amdgcn_s_setprio(1); _Pragma("unroll") for (int m = 0; m < 4; ++m) _Pragma("unroll") for (int n = 0; n < 2; ++n) _Pragma("unroll") for (int k = 0; k < 2; ++k) \
        acc[ai][bj][m][n] = __builtin_amdgcn_mfma_f32_16x16x32_bf16(Bt[n][k], At[m][k], acc[ai][bj][m][n], 0, 0, 0); __builtin_amdgcn_s_setprio(0); } while (0)
#define PG8_WAIT_V(n) asm volatile("s_waitcnt vmcnt(" #n ")" ::: "memory")
#define PG8_WAIT_L(n) asm volatile("s_waitcnt lgkmcnt(" #n ")" ::: "memory")
#define PG8_BAR __builtin_amdgcn_s_barrier()
#define PG8_SCHED __builtin_amdgcn_sched_barrier(0)
    Unit cur, nxt; int ui = 0;
    if (!S.next(0, cur)) return;
    const LAS float* rtab = (const LAS float*)(lds + RTAB_OFF);
    if constexpr (Epi::HSCALE) {
        if (tid < 256) {
            f32x4 q;
#pragma unroll
            for (int hh = 0; hh < 4; ++hh) { const float* sp = E.ssq + ((size_t)(cur.pm * BM + tid) * 4 + hh) * 8; const f32x4 s0 = *(const f32x4*)sp, s1 = *(const f32x4*)(sp + 4); q[hh] = ((s0[0] + s0[1]) + (s0[2] + s0[3])) + ((s1[0] + s1[1]) + (s1[2] + s1[3])); }
            const float i0 = rsqrtf(q[0] * (1.f / 512.f) + EPS), i1 = rsqrtf(q[1] * (1.f / 512.f) + EPS), i2 = rsqrtf(q[2] * (1.f / 512.f) + EPS), i3 = rsqrtf(q[3] * (1.f / 512.f) + EPS);
            *(LAS f32x4*)(lds + RTAB_OFF + tid * 16) = (f32x4){i0 / i1, i1 / i2, i2 / i3, i3};
        }
        __syncthreads();
    }
    f32x4 acc[2][2][4][2];
#pragma unroll
    for (int a = 0; a < 2; ++a)
#pragma unroll
        for (int b = 0; b < 2; ++b)
#pragma unroll
            for (int m = 0; m < 4; ++m)
#pragma unroll
                for (int n = 0; n < 2; ++n) acc[a][b][m][n] = (f32x4){0.f, 0.f, 0.f, 0.f};
    bf16x8 At[4][2], B0[2][2], B1[2][2];
    const char* cA = (const char*)g.A + (size_t)cur.pm * tstepA; const char* cB = (const char*)g.Bt + (size_t)cur.pn * tstepB;
    PG8_STAGE(PG8_SB(0, 0), cB, voffB); PG8_STAGE(PG8_SB(0, 1), cB + hstepB, voffB); PG8_STAGE(PG8_SA(0, 0), cA, voffA); PG8_STAGE(PG8_SA(0, 1), cA + hstepA, voffA);
    if (wr == 1) PG8_BAR;
    PG8_WAIT_V(2); PG8_BAR;
    PG8_STAGE(PG8_SB(1, 0), cB + kstep, voffB); PG8_STAGE(PG8_SA(1, 0), cA + kstep, voffA); PG8_STAGE(PG8_SB(1, 1), cB + hstepB + kstep, voffB);
    PG8_WAIT_V(6); PG8_BAR;
    for (;;) {
        const bool has_next = S.next(ui + 1, nxt);
        const char* nA = has_next ? (const char*)g.A + (size_t)nxt.pm * tstepA : cA; const char* nB = has_next ? (const char*)g.Bt + (size_t)nxt.pn * tstepB : cB;
        for (int t = 0; t < nt; t += 2) {
            const bool last = (t == nt - 2);
            const char* a1 = cA + (size_t)(t + 1) * kstep;
            const char* a2 = last ? nA : cA + (size_t)(t + 2) * kstep; const char* b2 = last ? nB : cB + (size_t)(t + 2) * kstep;
            const char* a3 = a2 + kstep; const char* b3 = b2 + kstep;
            PG8_LDB(B0, 0, 0); PG8_LDB(B1, 0, 1); PG8_SCHED; PG8_LDA(At, 0, 0); PG8_STAGE(PG8_SA(1, 1), a1 + hstepA, voffA);
            PG8_WAIT_V(8); PG8_WAIT_L(0); PG8_BAR; PG8_MMA(0, 0, At, B0); PG8_MMA(0, 1, At, B1); PG8_BAR; PG8_SCHED;
            PG8_LDA(At, 0, 1); PG8_STAGE(PG8_SB(0, 0), b2, voffB); PG8_STAGE(PG8_SB(0, 1), b2 + hstepB, voffB); PG8_STAGE(PG8_SA(0, 0), a2, voffA);
            PG8_WAIT_V(8); PG8_WAIT_L(0); PG8_BAR; PG8_MMA(1, 0, At, B0); PG8_MMA(1, 1, At, B1); PG8_BAR; PG8_SCHED;
            PG8_LDB(B0, 1, 0); PG8_LDB(B1, 1, 1); PG8_SCHED; PG8_LDA(At, 1, 0); PG8_STAGE(PG8_SA(0, 1), a2 + hstepA, voffA);
            PG8_WAIT_V(8); PG8_WAIT_L(0); PG8_BAR; PG8_MMA(0, 0, At, B0); PG8_MMA(0, 1, At, B1); PG8_BAR; PG8_SCHED;
            PG8_LDA(At, 1, 1); PG8_STAGE(PG8_SB(1, 0), b3, voffB); PG8_STAGE(PG8_SB(1, 1), b3 + hstepB, voffB); PG8_STAGE(PG8_SA(1, 0), a3, voffA);
            PG8_WAIT_V(8); PG8_WAIT_L(0); PG8_BAR; PG8_MMA(1, 0, At, B0); PG8_MMA(1, 1, At, B1); PG8_BAR; PG8_SCHED;
            if constexpr (Epi::HSCALE) {
                if (((t + 2) & 7) == 0 && t + 2 < nt) {
                    const int hb = ((t + 2) >> 3) - 1;
#pragma unroll
                    for (int ai = 0; ai < 2; ++ai)
#pragma unroll
                        for (int m = 0; m < 4; ++m) {
                            const float rt = rtab[(ai * HALF + wr * 64 + m * 16 + fr) * 4 + hb];
#pragma unroll
                            for (int bj = 0; bj < 2; ++bj)
#pragma unroll
                                for (int n = 0; n < 2; ++n) acc[ai][bj][m][n] = acc[ai][bj][m][n] * rt;
                        }
                }
            }
        }
        if constexpr (ALIGN_EPI) { if (wr == 0) PG8_BAR; }
        if constexpr (Epi::HSCALE) E(acc, cur, wr, wc, fr, fq, rtab); else E(acc, cur, wr, wc, fr, fq);
        if (!has_next) break;
#pragma unroll
        for (int a = 0; a < 2; ++a)
#pragma unroll
            for (int b = 0; b < 2; ++b)
#pragma unroll
                for (int m = 0; m < 4; ++m)
#pragma unroll
                    for (int n = 0; n < 2; ++n) acc[a][b][m][n] = (f32x4){0.f, 0.f, 0.f, 0.f};
        cur = nxt; cA = nA; cB = nB; ++ui;
        if constexpr (ALIGN_EPI) { if (wr == 1) PG8_BAR; }
    }
    PG8_WAIT_V(0);
    if constexpr (!ALIGN_EPI) { if (wr == 0) PG8_BAR; }
    PG8_BAR;
#undef PG8_SA
#undef PG8_SB
#undef PG8_STAGE
#undef PG8_LDA
#undef PG8_LDB
#undef PG8_MMA
#undef PG8_WAIT_V
#undef PG8_WAIT_L
#undef PG8_BAR
#undef PG8_SCHED
}
}

typedef short s16x4 __attribute__((ext_vector_type(4)));
#define MFMA16(a, b, c) __builtin_amdgcn_mfma_f32_16x16x32_bf16((a), (b), (c), 0, 0, 0)
__device__ __forceinline__ s16x4 ld_tr4(const LAS bf16_t* p) { return __builtin_amdgcn_ds_read_tr16_b64_v4i16((LAS s16x4*)p); }
__device__ __forceinline__ bf16x8 cat8(s16x4 lo, s16x4 hi) { return __builtin_shufflevector(lo, hi, 0, 1, 2, 3, 4, 5, 6, 7); }
__device__ __forceinline__ bf16x8 frag_tr(const LAS bf16_t* img, int ld, int k0, int n0, int lane) {
    const int g = lane >> 4, i = lane & 15, q = i >> 2, p = i & 3;
    const LAS bf16_t* a = img + (k0 + 8 * g + q) * ld + n0 + 4 * p;
    return cat8(ld_tr4(a), ld_tr4(a + 4 * ld));
}
__device__ __forceinline__ bf16x8 frag_rm(const LAS bf16_t* img, int ld, int m0, int k0, int lane) {
    return *(const LAS bf16x8*)(img + (m0 + (lane & 15)) * ld + k0 + 8 * (lane >> 4));
}


#define XB_TMO      128
#define XB_XCNT(j)  (256  + 64 * (j))
#define XB_XSUB(j)  (1280 + 64 * (j))
#define XB_XGEN(j)  (2304 + 64 * (j))
#define XB_TOP      3328
#define XB_TOPGEN   3392
#define XCD_BAR_WORDS 3456
#define XB_SPIN_CAP (1u << 18)
__device__ __forceinline__ unsigned xb_ld(unsigned* p)              { return __hip_atomic_load(p, __ATOMIC_RELAXED, __HIP_MEMORY_SCOPE_AGENT); }
__device__ __forceinline__ unsigned xb_add(unsigned* p, unsigned v) { return __hip_atomic_fetch_add(p, v, __ATOMIC_RELAXED, __HIP_MEMORY_SCOPE_AGENT); }
__device__ __forceinline__ unsigned xb_xcc_id() { return (unsigned)__builtin_amdgcn_s_getreg((3 << 11) | 20) & 0xFu; }
#define XB_SPIN(cond, bar) do { unsigned _sp = 0; while (cond) { __builtin_amdgcn_s_sleep(1); \
    if ((++_sp & 255u) == 0u) { if (xb_ld(&(bar)[XB_TMO])) break; if (_sp > XB_SPIN_CAP) { atomicAdd(&(bar)[XB_TMO], 1u); break; } } } } while (0)
struct XcdBarrier { unsigned* bar; unsigned x; volatile LAS unsigned* st; int wv; };
__device__ __forceinline__ XcdBarrier xcd_barrier_post(unsigned* bar, volatile LAS unsigned* st, int wv) {
    XcdBarrier b; b.bar = bar; b.x = xb_xcc_id(); b.st = st; b.wv = wv;
    if (wv == 0 && lane_id() == 0) (void)xb_add(&bar[XB_XCNT(b.x)], 1u);
    return b;
}
__device__ __forceinline__ void xcd_barrier_complete(unsigned* bar, unsigned x, unsigned& nloc, unsigned& nx) {
    const unsigned G = gridDim.x * gridDim.y * gridDim.z;
    unsigned sum, cnt, mine, sp = 0u;
    for (;;) {
        sum = 0u; cnt = 0u; mine = 0u;
#pragma unroll
        for (unsigned j = 0; j < 16; ++j) { const unsigned c = xb_ld(&bar[XB_XCNT(j)]); sum += c; cnt += (c > 0u) ? 1u : 0u; mine = (j == x) ? c : mine; }
        if (sum == G) break;
        __builtin_amdgcn_s_sleep(1);
        if ((++sp & 255u) == 0u) { if (xb_ld(&bar[XB_TMO])) break; if (sp > XB_SPIN_CAP) { atomicAdd(&bar[XB_TMO], 1u); break; } }
    }
    nloc = mine > 0u ? mine : 1u; nx = cnt > 0u ? cnt : 1u;
}
__device__ __forceinline__ void xcd_barrier(const XcdBarrier& b) {
    asm volatile("s_waitcnt vmcnt(0)" ::: "memory");
    __syncthreads();
    if (b.wv == 0 && lane_id() == 0) {
        unsigned* bar = b.bar;
        __builtin_amdgcn_s_waitcnt(0);
        unsigned nloc = b.st[0], nx = b.st[1];
        if (nloc == 0u) { xcd_barrier_complete(bar, b.x, nloc, nx); b.st[0] = nloc; b.st[1] = nx; }
        const unsigned old = xb_add(&bar[XB_XSUB(b.x)], 1u);
        const unsigned gen = old / nloc;
        if (old + 1u == (gen + 1u) * nloc) {
            __builtin_amdgcn_fence(__ATOMIC_RELEASE, "agent");
            asm volatile("s_waitcnt vmcnt(0)" ::: "memory");
            const unsigned og = xb_add(&bar[XB_TOP], 1u);
            const unsigned tg = og / nx;
            if (og + 1u == (tg + 1u) * nx) xb_add(&bar[XB_TOPGEN], 1u);
            else XB_SPIN(xb_ld(&bar[XB_TOPGEN]) == tg, bar);
            __builtin_amdgcn_fence(__ATOMIC_ACQUIRE, "agent");
            xb_add(&bar[XB_XGEN(b.x)], 1u);
            asm volatile("s_waitcnt vmcnt(0)" ::: "memory");
        } else {
            XB_SPIN(xb_ld(&bar[XB_XGEN(b.x)]) == gen, bar);
            __builtin_amdgcn_fence(__ATOMIC_ACQUIRE, "agent");
            asm volatile("s_waitcnt vmcnt(0)" ::: "memory");
        }
    }
    __syncthreads();
}

struct Args {
    const float* in[25]; float* out; unsigned char* ws;
};

__device__ __forceinline__ void transpose_item(const float* W, int ldw, int K, const float* scale, bf16_t* WT, int k0, int n0, int c0, LAS float* scr, int lane) {
#pragma unroll 8
    for (int i = 0; i < 32; ++i) { const int kk = 2 * i + (lane >> 5); float w = W[(size_t)(k0 + kk) * ldw + c0 + (lane & 31)]; if (scale) w *= scale[k0 + kk]; scr[kk * 33 + (lane & 31)] = w; }
    asm volatile("s_waitcnt lgkmcnt(0)" ::: "memory");
    const int c = lane & 7;
#pragma unroll
    for (int j = 0; j < 4; ++j) { const int n = (lane >> 3) + 8 * j; const LAS float* s = scr + (8 * c) * 33 + n;
        u32x4 o; o.x = pk2(s[0 * 33], s[1 * 33]); o.y = pk2(s[2 * 33], s[3 * 33]); o.z = pk2(s[4 * 33], s[5 * 33]); o.w = pk2(s[6 * 33], s[7 * 33]);
        *(u32x4*)(WT + (size_t)(n0 + n) * K + k0 + 8 * c) = o; }
    asm volatile("s_waitcnt lgkmcnt(0)" ::: "memory");
}
__device__ __forceinline__ int colmap0(int n) {
    if (n < 2048) return n;
    if (n < 3072) return 3080 + (n - 2048);
    if (n < 4096) return 2048 + (n - 3072);
    if (n < 5120) return 5128 + (n - 4096);
    return 4104 + (n - 5120);
}
__device__ __forceinline__ void convert_weight(const float* W, int ldw, int K, int N, const float* scale, int mode, bf16_t* WT, LAS float* scr, int gw, int ngw, int lane) {
    const int nblk = N / 32, nitems = (K / 64) * nblk;
    for (int it = gw; it < nitems; it += ngw) {
        const int kb = it / nblk, nb = it % nblk, n0 = nb * 32;
        transpose_item(W, ldw, K, scale, WT, kb * 64, n0, mode ? colmap0(n0) : n0, scr, lane);
    }
}

template <int NC>
__device__ __forceinline__ void rows_prep(const float* X, const float* g, const float* W, int ldw, int col0, const float* bias_a, const float* bias_b,
                                          bf16_t* HN, float* rowsq, float* G, LAS float* sW, int gw, int ngw, int lane, int wv) {
#pragma unroll 4
    for (int i = wv * 64 + lane; i < 1024 * NC; i += NTHREADS) { const int k = i / NC, c = i % NC; sW[c * 1024 + k] = g[k] * W[(size_t)k * ldw + col0 + c]; }
    __syncthreads();
#pragma unroll 1
    for (int row = gw; row < M_; row += ngw) {
        const float* xr = X + (size_t)row * DM;
        float ss = 0.f;
        f32x4 xv[4];
#pragma unroll
        for (int j = 0; j < 4; ++j) xv[j] = *(const f32x4*)(xr + j * 256 + lane * 4);
#pragma unroll
        for (int j = 0; j < 4; ++j) {
            const f32x4 v = xv[j];
            ss += v[0] * v[0] + v[1] * v[1] + v[2] * v[2] + v[3] * v[3];
            u32x2 o; o.x = pk2(v[0], v[1]); o.y = pk2(v[2], v[3]);
            *(u32x2*)(HN + (size_t)row * DM + j * 256 + lane * 4) = o;
        }
        ss = wave_sum(ss);
        const float inv = rsqrtf(ss * (1.f / DM) + EPS);
        if (lane == 0) rowsq[row] = ss;
        float mine = 0.f;
#pragma unroll
        for (int c = 0; c < NC; ++c) {
            float dsum = 0.f;
#pragma unroll
            for (int j = 0; j < 4; ++j) { const f32x4 w4 = *(const LAS f32x4*)(sW + c * 1024 + j * 256 + lane * 4); dsum += (xv[j][0] * w4[0] + xv[j][1] * w4[1]) + (xv[j][2] * w4[2] + xv[j][3] * w4[3]); }
            dsum = wave_sum(dsum) * inv;
            if (bias_a) dsum += (c < NC / 2) ? bias_a[c] : bias_b[c - NC / 2];
            mine = (lane == c) ? dsum : mine;
            __builtin_amdgcn_sched_barrier(0);
        }
        if (lane < NC) G[(size_t)row * NC + lane] = mine;
    }
    __syncthreads();
}


__device__ __forceinline__ float wave_scan_add(float v, int lane) {
#pragma unroll
    for (int o = 1; o < 64; o <<= 1) { const float y = __shfl_up(v, o); if (lane >= o) v += y; }
    return v;
}
__device__ __forceinline__ float wave_scan_max(float v, int lane) {
#pragma unroll
    for (int o = 1; o < 64; o <<= 1) { const float y = __shfl_up(v, o); if (lane >= o) v = fmaxf(v, y); }
    return v;
}
template <int CTRL> __device__ __forceinline__ float dpp_f(float v) { return __builtin_bit_cast(float, __builtin_amdgcn_update_dpp(0, __builtin_bit_cast(int, v), CTRL, 0xf, 0xf, false)); }
__device__ __forceinline__ float red16(float v) { v += dpp_f<0x128>(v); v += dpp_f<0x124>(v); v += dpp_f<0x122>(v); v += dpp_f<0x121>(v); return v; }
__device__ __forceinline__ float red8(float v) { v += dpp_f<0xB1>(v); v += dpp_f<0x4E>(v); v += dpp_f<0x141>(v); return v; }
constexpr int ML_LDK = 136, ML_LDV = 264, ML_LDS = 72;

constexpr int ML_NSEG = 8, ML_SEGLEN = SEQ / ML_NSEG;
constexpr size_t SCR_XE = 0, SCR_CSEG = 4 * MiB, SCR_NSEG = 40 * MiB, SCR_SCAL = 41 * MiB;
__device__ __forceinline__ void mlstm_passA(const bf16_t* P, const float* gif, const float* conv_w, const float* conv_b, float* CSEG, float* NSEGN, float* SCAL, LAS unsigned char* lds, int item, int wv) {
    int tid_ = wv * 64 + lane_id(); asm volatile("" : "+v"(tid_));
    const int tid0 = tid_, wave = __builtin_amdgcn_readfirstlane(tid0 >> 6);
    const int seg = item & 7, bh = item >> 3, b = bh >> 2, h = bh & 3;
    LAS bf16_t* Ks = (LAS bf16_t*)lds;
    LAS bf16_t* Vs = Ks + 64 * ML_LDK;
    LAS float* sw = (LAS float*)(Vs + 64 * ML_LDV);
    LAS float* sred = sw + 256;
    const size_t row0 = (size_t)b * SEQ + seg * ML_SEGLEN;
    {
        const int lane = tid0 & 63;
        float G = 0.f, ip = 0.f;
        if (tid0 < 256) { const float lf = logsigmoidf_(gif[(row0 + tid0) * 8 + 4 + h]); ip = gif[(row0 + tid0) * 8 + h]; G = wave_scan_add(lf, lane); if (lane == 63) sred[wave] = G; }
        __syncthreads();
        float a = -3.0e38f;
        const float Gtot = (sred[0] + sred[1]) + (sred[2] + sred[3]);
        if (tid0 < 256) { float off = 0.f; for (int w = 0; w < wave; ++w) off += sred[w]; G += off; a = Gtot - G + ip; }
        float mx = a;
#pragma unroll
        for (int o = 1; o < 64; o <<= 1) mx = fmaxf(mx, __shfl_xor(mx, o));
        if (lane == 0) sred[8 + wave] = mx;
        __syncthreads();
        const float mseg = fmaxf(fmaxf(sred[8], sred[9]), fmaxf(sred[10], sred[11]));
        if (tid0 < 256) sw[tid0] = __expf(a - mseg);
        if (tid0 == 0) { SCAL[item * 2] = Gtot; SCAL[item * 2 + 1] = mseg; }
    }
    f32x4 C[8][2];
#pragma unroll
    for (int i = 0; i < 8; ++i) { C[i][0] = (f32x4){0.f, 0.f, 0.f, 0.f}; C[i][1] = (f32x4){0.f, 0.f, 0.f, 0.f}; }
    float nacc = 0.f;
    const int ch = tid0 & 127, tq = tid0 >> 7, cch = 512 + h * 128 + ch;
    const float w0 = conv_w[cch], w1 = conv_w[1024 + cch], w2 = conv_w[2048 + cch], w3 = conv_w[3072 + cch], cb = conv_b[cch];
    __syncthreads();
    for (int c = 0; c < 4; ++c) {
        const int t0 = seg * ML_SEGLEN + c * 64;
        const size_t rowg = (size_t)b * SEQ + t0;
        {
            int tid = tid0; asm volatile("" : "+v"(tid));
            const int ts = tq * 16, tg = t0 + ts;
            const bf16_t* src = P + (rowg + ts) * NP + cch;
            float r0 = (tg >= 3) ? bf2f(src[-3 * NP]) : 0.f, r1 = (tg >= 2) ? bf2f(src[-2 * NP]) : 0.f, r2 = (tg >= 1) ? bf2f(src[-1 * NP]) : 0.f;
#pragma unroll 8
            for (int tt = 0; tt < 16; ++tt) {
                const float raw = bf2f(src[(size_t)tt * NP]);
                const float cv = w0 * r0 + w1 * r1 + w2 * r2 + w3 * raw + cb;
                r0 = r1; r1 = r2; r2 = raw;
                Ks[(ts + tt) * ML_LDK + ch] = f2bf(siluf_(cv) * sw[c * 64 + ts + tt]);
            }
#pragma unroll
            for (int j = 0; j < 4; ++j) { const int idx = tid + NTHREADS * j, row = idx >> 5, cc = idx & 31;
                *(LAS u32x4*)(Vs + row * ML_LDV + cc * 8) = *(const u32x4*)(P + (rowg + row) * NP + 1024 + h * 256 + cc * 8); }
        }
        __syncthreads();
        {
            int tid = tid0; asm volatile("" : "+v"(tid)); const int lane = tid & 63;
            if (tid < 128) {
#pragma unroll 8
                for (int srow = 0; srow < 64; ++srow) nacc += bf2f(Ks[srow * ML_LDK + tid]);
            }
#pragma unroll
            for (int ks = 0; ks < 2; ++ks) {
                const bf16x8 bv0 = frag_tr(Vs, ML_LDV, 32 * ks, 32 * wave, lane), bv1 = frag_tr(Vs, ML_LDV, 32 * ks, 32 * wave + 16, lane);
#pragma unroll
                for (int kt = 0; kt < 8; ++kt) { const bf16x8 af = frag_tr(Ks, ML_LDK, 32 * ks, 16 * kt, lane); C[kt][0] = MFMA16(af, bv0, C[kt][0]); C[kt][1] = MFMA16(af, bv1, C[kt][1]);
                    if (kt & 1) asm volatile("" ::: "memory"); }
            }
        }
        __syncthreads();
    }
    {
        int tid = tid0; asm volatile("" : "+v"(tid)); const int lane = tid & 63;
        float* cs = CSEG + ((size_t)item * 8 + wave) * 16 * 256 + lane * 4;
#pragma unroll
        for (int kt = 0; kt < 8; ++kt) { *(f32x4*)(cs + (kt * 2) * 256) = C[kt][0]; *(f32x4*)(cs + (kt * 2 + 1) * 256) = C[kt][1]; }
        if (tid < 128) NSEGN[(size_t)item * 128 + tid] = nacc;
    }
}

__device__ __forceinline__ void mlstm_passB(bf16_t* P, const float* gif, const float* conv_w, const float* conv_b, const float* head_g, const float* CSEG, const float* NSEGN, const float* SCAL, LAS unsigned char* lds, int item, int nseg, int wv) {
    int tid_ = wv * 64 + lane_id(); asm volatile("" : "+v"(tid_));
    const int tid0 = tid_, wave = __builtin_amdgcn_readfirstlane(tid0 >> 6);
    const int seg = item % nseg, bh = item / nseg, b = bh >> 2, h = bh & 3, nchunk = 32 / nseg;
    LAS bf16_t* Qs = (LAS bf16_t*)lds;
    LAS bf16_t* Ks = Qs + 64 * ML_LDK;
    LAS bf16_t* Vs = Ks + 64 * ML_LDK;
    LAS bf16_t* SC = Vs + 64 * ML_LDV;
    LAS bf16_t* RAW = SC + 64 * ML_LDS;
    LAS float* sE0 = (LAS float*)(RAW + 68 * 256);
    LAS float* se0 = sE0 + 256; LAS float* sWi0 = se0 + 256; LAS float* sCl0 = sWi0 + 256; LAS float* sKw0 = sCl0 + 256; LAS float* sSc0 = sKw0 + 256;
    LAS float* denp = sSc0 + 16;
    LAS float* dnp = denp + 256;
    LAS float* sN = dnp + 64;
    f32x4 C[8][2];
#pragma unroll
    for (int i = 0; i < 8; ++i) { C[i][0] = (f32x4){0.f, 0.f, 0.f, 0.f}; C[i][1] = (f32x4){0.f, 0.f, 0.f, 0.f}; }
    const size_t rowseg = (size_t)b * SEQ + seg * (SEQ / nseg);
    u32x4 pr[5], pv[4];
#define ML_LOAD(c) do { int tl = tid0; asm volatile("" : "+v"(tl)); const int t0l = seg * (SEQ / nseg) + (c) * 64; const size_t rg = (size_t)b * SEQ + t0l; \
        _Pragma("unroll") for (int j = 0; j < 5; ++j) { const int idx = tl + NTHREADS * j, row = idx >> 5, cc = idx & 31; \
            const bool ok = (row < 67) && (t0l - 3 + row >= 0); const int rowc = ok ? row : 3; const unsigned msk = ok ? 0xffffffffu : 0u; \
            const bf16_t* src = P + (rg + rowc - 3) * NP + ((cc < 16) ? (h * 128 + cc * 8) : (512 + h * 128 + (cc - 16) * 8)); \
            const u32x4 ld = *(const u32x4*)src; pr[j] = (u32x4){ld.x & msk, ld.y & msk, ld.z & msk, ld.w & msk}; } } while (0)
    float m_prev = -1e30f;
    if (seg == 0) { if (tid0 < 128) sN[tid0] = 0.f; }
    else {
        int tid = tid0; asm volatile("" : "+v"(tid)); const int lane = tid & 63;
        const float* sc0 = SCAL + (size_t)(item - seg) * 2;
        float total = 0.f, m0 = -3.0e38f;
#pragma unroll 1
        for (int q = 0; q < seg; ++q) total += sc0[2 * q];
        { float pre = 0.f;
#pragma unroll 1
          for (int q = 0; q < seg; ++q) { pre += sc0[2 * q]; m0 = fmaxf(m0, (total - pre) + sc0[2 * q + 1]); } }
        float nn = 0.f, pre = 0.f;
#pragma unroll 1
        for (int q = 0; q < seg; ++q) {
            pre += sc0[2 * q];
            const float cf = __expf((total - pre) + sc0[2 * q + 1] - m0);
            const float* cs = CSEG + ((size_t)(item - seg + q) * 8 + wave) * 16 * 256 + lane * 4;
#pragma unroll
            for (int kt = 0; kt < 8; ++kt) { C[kt][0] += cf * *(const f32x4*)(cs + (kt * 2) * 256); C[kt][1] += cf * *(const f32x4*)(cs + (kt * 2 + 1) * 256); }
            if (tid < 128) nn += cf * NSEGN[(size_t)(item - seg + q) * 128 + tid];
        }
        if (tid < 128) sN[tid] = nn;
        m_prev = m0;
    }
    if (wave == 0) {
        int lane = tid0 & 63; asm volatile("" : "+v"(lane));
        float mp = m_prev;
        for (int c = 0; c < nchunk; ++c) {
            const size_t row = rowseg + c * 64 + lane;
            const float lf = logsigmoidf_(gif[row * 8 + 4 + h]), ip = gif[row * 8 + h];
            const float bc = wave_scan_add(lf, lane);
            const float e = ip - bc;
            const float E = fmaxf(wave_scan_max(e, lane), mp);
            const float E63 = __shfl(E, 63), g63 = __shfl(bc, 63);
            const int o = c * 64 + lane;
            sE0[o] = E; se0[o] = e; sWi0[o] = __expf(mp - E); sCl0[o] = __expf(-(bc + E)); sKw0[o] = __expf(e - E63);
            if (lane == 63) { sSc0[2 * c] = __expf(mp - E63); sSc0[2 * c + 1] = bc + E63; }
            mp = g63 + E63;
        }
    }
    const int ch = tid0 & 255, th = tid0 >> 8;
    const int cch = (ch < 128) ? (h * 128 + ch) : (512 + h * 128 + (ch - 128));
    const float w0 = conv_w[cch], w1 = conv_w[1024 + cch], w2 = conv_w[2048 + cch], w3 = conv_w[3072 + cch], cb = conv_b[cch];
    const float qscale = 0.08838834764831845f;
    ML_LOAD(0);
    for (int c = 0; c < nchunk; ++c) {
        const int t0 = seg * (SEQ / nseg) + c * 64;
        const size_t rowg = (size_t)b * SEQ + t0;
        LAS float* sE = sE0 + c * 64; LAS float* se = se0 + c * 64; LAS float* sWi = sWi0 + c * 64; LAS float* sCl = sCl0 + c * 64; LAS float* sKw = sKw0 + c * 64; LAS float* sSc = sSc0 + 2 * c;
        {
            int tid = tid0; asm volatile("" : "+v"(tid));
#pragma unroll
            for (int j = 0; j < 5; ++j) { const int idx = tid + NTHREADS * j; if (idx < 67 * 32) *(LAS u32x4*)(RAW + idx * 8) = pr[j]; }
#pragma unroll
            for (int j = 0; j < 4; ++j) { const int idx = tid + NTHREADS * j, row = idx >> 5, cc = idx & 31; pv[j] = *(const u32x4*)(P + (rowg + row) * NP + 1024 + h * 256 + cc * 8); }
        }
        __syncthreads();
        {
            int tid = tid0; asm volatile("" : "+v"(tid));
            const int ts = th * 32;
            const LAS bf16_t* src = RAW + ts * 256 + ((ch < 128) ? ch : (128 + (ch - 128)));
            float r0 = bf2f(src[0]), r1 = bf2f(src[256]), r2 = bf2f(src[512]);
            LAS bf16_t* dst = (ch < 128) ? (Qs + ts * ML_LDK + ch) : (Ks + ts * ML_LDK + (ch - 128));
            const float sc = (ch < 128) ? qscale : 1.f;
#pragma unroll 8
            for (int tt = 0; tt < 32; ++tt) {
                const float raw = bf2f(src[(tt + 3) * 256]);
                const float cv = w0 * r0 + w1 * r1 + w2 * r2 + w3 * raw + cb;
                r0 = r1; r1 = r2; r2 = raw;
                dst[tt * ML_LDK] = f2bf(siluf_(cv) * sc);
            }
#pragma unroll
            for (int j = 0; j < 4; ++j) { const int idx = tid + NTHREADS * j, row = idx >> 5, cc = idx & 31; *(LAS u32x4*)(Vs + row * ML_LDV + cc * 8) = pv[j]; }
        }
        __syncthreads();
        {
        int tid = tid0; asm volatile("" : "+v"(tid)); const int lane = tid & 63, g4 = lane >> 4, l15 = lane & 15; (void)g4; (void)l15;
#pragma unroll
        for (int j = 0; j < 2; ++j) {
            const int mt = wave >> 1, nt = 2 * (wave & 1) + j;
            f32x4 acc = {0.f, 0.f, 0.f, 0.f};
#pragma unroll
            for (int ks = 0; ks < 4; ++ks) acc = MFMA16(frag_rm(Qs, ML_LDK, 16 * mt, 32 * ks, lane), frag_rm(Ks, ML_LDK, 16 * nt, 32 * ks, lane), acc);
            const int sidx = 16 * nt + l15; const float es = se[sidx];
#pragma unroll
            for (int r = 0; r < 4; ++r) {
                const int t = 16 * mt + 4 * g4 + r;
                const float wgt = (sidx <= t) ? __expf(es - sE[t]) : 0.f;
                const float val = wgt * acc[r];
                SC[t * ML_LDS + sidx] = f2bf(val);
                const float rs = red16(val);
                if (l15 == 0) denp[t * 4 + nt] = rs;
            }
        }
        {
            const int t = tid >> 3, pp = tid & 7;
            float part = 0.f;
#pragma unroll
            for (int k = 0; k < 16; ++k) part += bf2f(Qs[t * ML_LDK + pp * 16 + k]) * sN[pp * 16 + k];
            part = red8(part);
            if (pp == 0) dnp[t] = part;
        }
        }
        __syncthreads();
        f32x4 num[4][2];
        {
        int tid = tid0; asm volatile("" : "+v"(tid)); const int lane = tid & 63, g4 = lane >> 4, l15 = lane & 15; (void)g4; (void)l15;
#pragma unroll
        for (int mt = 0; mt < 4; ++mt) { num[mt][0] = (f32x4){0.f, 0.f, 0.f, 0.f}; num[mt][1] = (f32x4){0.f, 0.f, 0.f, 0.f}; }
#pragma unroll
        for (int ks = 0; ks < 4; ++ks) {
            bf16x8 sb[2];
#pragma unroll
            for (int nt = 0; nt < 2; ++nt) { u32x4 sw; sw.x = pk2(C[2 * ks][nt][0], C[2 * ks][nt][1]); sw.y = pk2(C[2 * ks][nt][2], C[2 * ks][nt][3]);
                sw.z = pk2(C[2 * ks + 1][nt][0], C[2 * ks + 1][nt][1]); sw.w = pk2(C[2 * ks + 1][nt][2], C[2 * ks + 1][nt][3]); sb[nt] = __builtin_bit_cast(bf16x8, sw); }
#pragma unroll
            for (int mt = 0; mt < 4; ++mt) {
                const LAS bf16_t* ap = Qs + (16 * mt + l15) * ML_LDK + 32 * ks + 4 * g4;
                const bf16x8 af = cat8(*(const LAS s16x4*)ap, *(const LAS s16x4*)(ap + 16));
                num[mt][0] = MFMA16(af, sb[0], num[mt][0]); num[mt][1] = MFMA16(af, sb[1], num[mt][1]);
                if (mt & 1) asm volatile("" ::: "memory");
            }
        }
#pragma unroll
        for (int mt = 0; mt < 4; ++mt)
#pragma unroll
            for (int r = 0; r < 4; ++r) { const float wi = sWi[16 * mt + 4 * g4 + r]; num[mt][0][r] *= wi; num[mt][1][r] *= wi; }
#pragma unroll
        for (int ks = 0; ks < 2; ++ks) {
            const bf16x8 bv0 = frag_tr(Vs, ML_LDV, 32 * ks, 32 * wave, lane), bv1 = frag_tr(Vs, ML_LDV, 32 * ks, 32 * wave + 16, lane);
#pragma unroll
            for (int mt = 0; mt < 4; ++mt) { const bf16x8 af = frag_rm(SC, ML_LDS, 16 * mt, 32 * ks, lane); num[mt][0] = MFMA16(af, bv0, num[mt][0]); num[mt][1] = MFMA16(af, bv1, num[mt][1]); }
            asm volatile("" ::: "memory");
        }
#pragma unroll
        for (int mt = 0; mt < 4; ++mt)
#pragma unroll
            for (int r = 0; r < 4; ++r) {
                const int t = 16 * mt + 4 * g4 + r;
                const float den = (denp[t * 4] + denp[t * 4 + 1]) + (denp[t * 4 + 2] + denp[t * 4 + 3]) + sWi[t] * dnp[t];
                const float dd = __builtin_amdgcn_rcpf(fmaxf(fabsf(den), sCl[t]));
                num[mt][0][r] *= dd; num[mt][1][r] *= dd;
            }
        }
        {
        int tid = tid0; asm volatile("" : "+v"(tid)); const int lane = tid & 63, g4 = lane >> 4, l15 = lane & 15; (void)g4; (void)l15;
#pragma unroll
        for (int j = 0; j < 8; ++j) { const int idx = tid + NTHREADS * j, srow = idx >> 6, kp = idx & 63;
            LAS unsigned* wp = (LAS unsigned*)(Ks + srow * ML_LDK + 2 * kp); const unsigned wv = *wp; const float kwt = sKw[srow];
            *wp = pk2(bflo(wv) * kwt, bfhi(wv) * kwt); }
        }
        const float cs = sSc[0], m_new = sSc[1];
        __syncthreads();
        {
        int tid = tid0; asm volatile("" : "+v"(tid)); const int lane = tid & 63, g4 = lane >> 4, l15 = lane & 15; (void)g4; (void)l15;
        if (tid < 128) { float an = cs * sN[tid];
#pragma unroll 8
            for (int srow = 0; srow < 64; ++srow) an += bf2f(Ks[srow * ML_LDK + tid]);
            sN[tid] = an; }
#pragma unroll
        for (int i = 0; i < 8; ++i) { C[i][0] = C[i][0] * cs; C[i][1] = C[i][1] * cs; }
#pragma unroll
        for (int ks = 0; ks < 2; ++ks) {
            const bf16x8 bv0 = frag_tr(Vs, ML_LDV, 32 * ks, 32 * wave, lane), bv1 = frag_tr(Vs, ML_LDV, 32 * ks, 32 * wave + 16, lane);
#pragma unroll
            for (int kt = 0; kt < 8; ++kt) { const bf16x8 af = frag_tr(Ks, ML_LDK, 32 * ks, 16 * kt, lane); C[kt][0] = MFMA16(af, bv0, C[kt][0]); C[kt][1] = MFMA16(af, bv1, C[kt][1]);
                if (kt & 1) asm volatile("" ::: "memory"); }
        }
        }
        __syncthreads();
        {
        int tid = tid0; asm volatile("" : "+v"(tid)); const int lane = tid & 63, g4 = lane >> 4, l15 = lane & 15; (void)g4; (void)l15;
#pragma unroll
        for (int mt = 0; mt < 4; ++mt)
#pragma unroll
            for (int r = 0; r < 4; ++r) { LAS bf16_t* hp = Vs + (16 * mt + 4 * g4 + r) * ML_LDV + 32 * wave + l15; hp[0] = f2bf(num[mt][0][r]); hp[16] = f2bf(num[mt][1][r]); }
        }
        __syncthreads();
        {
            int tid = tid0; asm volatile("" : "+v"(tid)); const int lane = tid & 63, g4 = lane >> 4, l15 = lane & 15; (void)g4; (void)l15;
            if (c + 1 < nchunk) ML_LOAD(c + 1);
            const int t = tid >> 3, pp = tid & 7;
            bf16_t* prow = P + (rowg + t) * NP + h * 256 + pp * 32;
            float q2 = 0.f;
#pragma unroll
            for (int j = 0; j < 4; ++j) {
                LAS u32x4* hp = (LAS u32x4*)(Vs + t * ML_LDV + pp * 32 + 8 * j);
                const u32x4 hv = *hp;
                const u32x4 ov = *(const u32x4*)(prow + 3072 + 8 * j);
                const unsigned hw[4] = {hv.x, hv.y, hv.z, hv.w}, ow[4] = {ov.x, ov.y, ov.z, ov.w};
                unsigned vw[4];
#pragma unroll
                for (int e = 0; e < 4; ++e) { const float a0 = sigmoidf_(bflo(ow[e])) * bflo(hw[e]), a1 = sigmoidf_(bfhi(ow[e])) * bfhi(hw[e]);
                    vw[e] = pk2(a0, a1); q2 += a0 * a0 + a1 * a1; }
                *hp = (u32x4){vw[0], vw[1], vw[2], vw[3]};
            }
            q2 = red8(q2);
            const float inv = rsqrtf(q2 * (1.f / 256.f) + EPS);
#pragma unroll
            for (int j = 0; j < 4; ++j) {
                const u32x4 vv = *(const LAS u32x4*)(Vs + t * ML_LDV + pp * 32 + 8 * j);
                const u32x4 zv = *(const u32x4*)(prow + 5120 + 8 * j);
                const f32x4 ga = *(const f32x4*)(head_g + h * 256 + pp * 32 + 8 * j), gb = *(const f32x4*)(head_g + h * 256 + pp * 32 + 8 * j + 4);
                const unsigned zw[4] = {zv.x, zv.y, zv.z, zv.w}, vw[4] = {vv.x, vv.y, vv.z, vv.w};
                float o8[8];
#pragma unroll
                for (int e = 0; e < 4; ++e) {
                    const float g0 = (e < 2) ? ga[2 * e] : gb[2 * e - 4], g1 = (e < 2) ? ga[2 * e + 1] : gb[2 * e - 3];
                    o8[2 * e] = bflo(vw[e]) * inv * g0 * siluf_(bflo(zw[e]));
                    o8[2 * e + 1] = bfhi(vw[e]) * inv * g1 * siluf_(bfhi(zw[e]));
                }
                u32x4 w; w.x = pk2(o8[0], o8[1]); w.y = pk2(o8[2], o8[3]); w.z = pk2(o8[4], o8[5]); w.w = pk2(o8[6], o8[7]);
                *(u32x4*)(prow + 3072 + 8 * j) = w;
                if (j & 1) asm volatile("" ::: "memory");
            }
        }
        (void)m_new;
        __syncthreads();
    }
}


typedef float f32x16 __attribute__((ext_vector_type(16)));
#define MFMA32(a, b, c) __builtin_amdgcn_mfma_f32_32x32x16_bf16((a), (b), (c), 0, 0, 0)
constexpr int S5_SEGS = 8, S5_SEGLEN = SEQ / S5_SEGS, S5_LD = 168, S5_IMG_BYTES = 2 * 16 * S5_LD * 2;
struct S5Lane { float ar[2], ai[2]; bf16x8 bt[4]; };
__device__ __forceinline__ void s5_lane_consts(S5Lane& L, const float* lam_re, const float* lam_im, const float* log_dt, const float* b_re, const float* b_im, int g, int n, int hh) {
    const float dt = expf(log_dt[g]);
#pragma unroll
    for (int pi = 0; pi < 2; ++pi) {
        const int p = n + 32 * pi;
        const float lr = lam_re[g * 64 + p], li = lam_im[g * 64 + p];
        const float ex = expf(lr * dt), cs = cosf(li * dt), sn = sinf(li * dt);
        const float ar = ex * cs, ai = ex * sn, s2 = sinf(0.5f * li * dt);
        const float a1r = expm1f(lr * dt) * cs - 2.f * s2 * s2, a1i = ai, den = lr * lr + li * li;
        const float qr = (a1r * lr + a1i * li) / den, qi = (a1i * lr - a1r * li) / den;
        L.ar[pi] = ar; L.ai[pi] = ai;
        const f32x4 br0 = *(const f32x4*)(b_re + (size_t)(g * 64 + p) * 16 + 8 * hh), br1 = *(const f32x4*)(b_re + (size_t)(g * 64 + p) * 16 + 8 * hh + 4);
        const f32x4 bi0 = *(const f32x4*)(b_im + (size_t)(g * 64 + p) * 16 + 8 * hh), bi1 = *(const f32x4*)(b_im + (size_t)(g * 64 + p) * 16 + 8 * hh + 4);
        u32x4 wre, wim;
        wre.x = pk2(br0[0] * qr - bi0[0] * qi, br0[1] * qr - bi0[1] * qi); wre.y = pk2(br0[2] * qr - bi0[2] * qi, br0[3] * qr - bi0[3] * qi);
        wre.z = pk2(br1[0] * qr - bi1[0] * qi, br1[1] * qr - bi1[1] * qi); wre.w = pk2(br1[2] * qr - bi1[2] * qi, br1[3] * qr - bi1[3] * qi);
        wim.x = pk2(br0[0] * qi + bi0[0] * qr, br0[1] * qi + bi0[1] * qr); wim.y = pk2(br0[2] * qi + bi0[2] * qr, br0[3] * qi + bi0[3] * qr);
        wim.z = pk2(br1[0] * qi + bi1[0] * qr, br1[1] * qi + bi1[1] * qr); wim.w = pk2(br1[2] * qi + bi1[2] * qr, br1[3] * qi + bi1[3] * qr);
        L.bt[pi] = __builtin_bit_cast(bf16x8, wre); L.bt[2 + pi] = __builtin_bit_cast(bf16x8, wim);
    }
}
__device__ __forceinline__ const bf16_t* s5_urow(const bf16_t* P, int bp, int g, int t0, int lane) {
    const int m = lane & 31, hh = lane >> 5, sq = (m >> 2) & 1, tok = (m >> 3) * 4 + (m & 3);
    return P + ((size_t)(2 * bp + sq) * SEQ + t0 + tok) * NP + 2048 + g * 16 + 8 * hh;
}
__device__ __forceinline__ void s5_passA(const bf16_t* P, const float* lam_re, const float* lam_im, const float* log_dt, const float* b_re, const float* b_im, float* XE, int item, int lane) {
    const int seg = item & 7, g = (item >> 3) & 63, bp = item >> 9, n = lane & 31, hh = lane >> 5;
    S5Lane L; s5_lane_consts(L, lam_re, lam_im, log_dt, b_re, b_im, g, n, hh);
    float x0r = 0.f, x0i = 0.f, x1r = 0.f, x1i = 0.f;
    const f32x16 zero = {0.f, 0.f, 0.f, 0.f, 0.f, 0.f, 0.f, 0.f, 0.f, 0.f, 0.f, 0.f, 0.f, 0.f, 0.f, 0.f};
    const bf16_t* up = s5_urow(P, bp, g, seg * S5_SEGLEN, lane);
    bf16x8 af = *(const bf16x8*)up;
    for (int blk = 0; blk < S5_SEGLEN / 16; ++blk) {
        const bf16x8 cur = af;
        if (blk + 1 < S5_SEGLEN / 16) af = *(const bf16x8*)(up + (size_t)(blk + 1) * 16 * NP);
        const f32x16 d0 = MFMA32(cur, L.bt[0], zero), d1 = MFMA32(cur, L.bt[1], zero), d2 = MFMA32(cur, L.bt[2], zero), d3 = MFMA32(cur, L.bt[3], zero);
#pragma unroll
        for (int r = 0; r < 16; ++r) {
            const float n0r = L.ar[0] * x0r - L.ai[0] * x0i + d0[r], n0i = L.ar[0] * x0i + L.ai[0] * x0r + d2[r];
            const float n1r = L.ar[1] * x1r - L.ai[1] * x1i + d1[r], n1i = L.ar[1] * x1i + L.ai[1] * x1r + d3[r];
            x0r = n0r; x0i = n0i; x1r = n1r; x1i = n1i;
        }
    }
    *(f32x4*)(XE + ((size_t)item * 64 + lane) * 4) = (f32x4){x0r, x0i, x1r, x1i};
}
__device__ __forceinline__ void s5_passB(bf16_t* P, const float* lam_re, const float* lam_im, const float* log_dt, const float* b_re, const float* b_im,
                                         const float* c_re, const float* c_im, const float* dskip, const float* XE, LAS bf16_t* img, int item, int lane) {
    const int seg = item & 7, g = (item >> 3) & 63, bp = item >> 9, n = lane & 31, hh = lane >> 5, l15 = lane & 15, g4 = lane >> 4;
    S5Lane L; s5_lane_consts(L, lam_re, lam_im, log_dt, b_re, b_im, g, n, hh);
    bf16x8 ct[5];
#pragma unroll
    for (int ks = 0; ks < 4; ++ks) {
        const int p0 = 8 * ks + 2 * g4;
        const float* cr = c_re + (size_t)(g * 16 + l15) * 64; const float* ci = c_im + (size_t)(g * 16 + l15) * 64;
        u32x4 w;
        w.x = pk2(cr[p0], cr[32 + p0]); w.y = pk2(-ci[p0], -ci[32 + p0]); w.z = pk2(cr[p0 + 1], cr[32 + p0 + 1]); w.w = pk2(-ci[p0 + 1], -ci[32 + p0 + 1]);
        ct[ks] = __builtin_bit_cast(bf16x8, w);
    }
    {
        const float dv = dskip[g * 16 + l15];
        u32x4 w = {0u, 0u, 0u, 0u};
        const int kq = l15 - 8 * g4;
        const unsigned dbits = (unsigned)f2bf(dv);
        if (g4 < 2 && kq >= 0 && kq < 8) { const unsigned val = (kq & 1) ? (dbits << 16) : dbits; if ((kq >> 1) == 0) w.x = val; else if ((kq >> 1) == 1) w.y = val; else if ((kq >> 1) == 2) w.z = val; else w.w = val; }
        ct[4] = __builtin_bit_cast(bf16x8, w);
    }
    float x0r = 0.f, x0i = 0.f, x1r = 0.f, x1i = 0.f;
    {
        float p0r = L.ar[0], p0i = L.ai[0], p1r = L.ar[1], p1i = L.ai[1];
#pragma unroll
        for (int q = 0; q < 8; ++q) { const float t0r = p0r * p0r - p0i * p0i, t0i = 2.f * p0r * p0i, t1r = p1r * p1r - p1i * p1i, t1i = 2.f * p1r * p1i; p0r = t0r; p0i = t0i; p1r = t1r; p1i = t1i; }
        for (int sp = 0; sp < seg; ++sp) {
            const f32x4 xe = *(const f32x4*)(XE + ((size_t)(item - seg + sp) * 64 + lane) * 4);
            const float n0r = p0r * x0r - p0i * x0i + xe[0], n0i = p0r * x0i + p0i * x0r + xe[1];
            const float n1r = p1r * x1r - p1i * x1i + xe[2], n1i = p1r * x1i + p1i * x1r + xe[3];
            x0r = n0r; x0i = n0i; x1r = n1r; x1i = n1i;
        }
    }
    { const int row = lane >> 1, hf = lane & 1; if (row < 32) *(LAS u32x4*)(img + row * S5_LD + 144 + 8 * hf) = (u32x4){0u, 0u, 0u, 0u}; }
    const f32x16 zero = {0.f, 0.f, 0.f, 0.f, 0.f, 0.f, 0.f, 0.f, 0.f, 0.f, 0.f, 0.f, 0.f, 0.f, 0.f, 0.f};
    const bf16_t* up = s5_urow(P, bp, g, seg * S5_SEGLEN, lane);
    const int m = lane & 31, usq = (m >> 2) & 1, utok = (m >> 3) * 4 + (m & 3);
    bf16x8 af = *(const bf16x8*)up;
    for (int blk = 0; blk < S5_SEGLEN / 16; ++blk) {
        const bf16x8 cur = af;
        if (blk + 1 < S5_SEGLEN / 16) af = *(const bf16x8*)(up + (size_t)(blk + 1) * 16 * NP);
        *(LAS bf16x8*)(img + (usq * 16 + utok) * S5_LD + 128 + 8 * hh) = cur;
        const f32x16 d0 = MFMA32(cur, L.bt[0], zero), d1 = MFMA32(cur, L.bt[1], zero), d2 = MFMA32(cur, L.bt[2], zero), d3 = MFMA32(cur, L.bt[3], zero);
#pragma unroll
        for (int r = 0; r < 16; ++r) {
            const float n0r = L.ar[0] * x0r - L.ai[0] * x0i + d0[r], n0i = L.ar[0] * x0i + L.ai[0] * x0r + d2[r];
            const float n1r = L.ar[1] * x1r - L.ai[1] * x1i + d1[r], n1i = L.ar[1] * x1i + L.ai[1] * x1r + d3[r];
            x0r = n0r; x0i = n0i; x1r = n1r; x1i = n1i;
            u32x2 w; w.x = pk2(x0r, x1r); w.y = pk2(x0i, x1i);
            *(LAS u32x2*)(img + (hh * 16 + r) * S5_LD + 4 * n) = w;
        }
        asm volatile("s_waitcnt lgkmcnt(0)" ::: "memory");
#pragma unroll
        for (int sq = 0; sq < 2; ++sq) {
            f32x4 y = {0.f, 0.f, 0.f, 0.f};
#pragma unroll
            for (int ks = 0; ks < 5; ++ks) y = MFMA16(frag_rm(img + sq * 16 * S5_LD, S5_LD, 0, 32 * ks, lane), ct[ks], y);
            bf16_t* op = P + ((size_t)(2 * bp + sq) * SEQ + seg * S5_SEGLEN + blk * 16 + 4 * g4) * NP + 2048 + g * 16 + l15;
#pragma unroll
            for (int r = 0; r < 4; ++r) {
                const float v = y[r], uu = 0.7978845608028654f * (v + 0.044715f * v * v * v);
                const float th = 1.f - 2.f * __builtin_amdgcn_rcpf(__expf(2.f * uu) + 1.f);
                op[(size_t)r * NP] = f2bf(0.5f * v * (1.f + th));
            }
        }
        asm volatile("s_waitcnt lgkmcnt(0)" ::: "memory");
    }
}


constexpr int GL_LDQ = 264, GL_LDA = 72;
__device__ __forceinline__ void gla_prep(bf16_t* P, const bf16_t* HN, const bf16_t* WRT, const float* rsq, const float* w_alpha, const float* b_alpha, bf16_t* ATT, float* EG, LAS unsigned char* lds, int bx, int G, int wv) {
    int tid_ = wv * 64 + lane_id(); asm volatile("" : "+v"(tid_));
    const int tid = tid_, lane = tid & 63, wave = __builtin_amdgcn_readfirstlane(tid >> 6);
    LAS bf16_t* Qs = (LAS bf16_t*)lds;
    LAS bf16_t* Ks = Qs + 64 * GL_LDQ;
    LAS bf16_t* Ke = Ks + 64 * GL_LDQ;
    LAS float* sR = (LAS float*)(lds + 3 * 64 * GL_LDQ * 2);
    LAS float* tot = sR + 1024;
    LAS float* rpart = tot + 512;
    const int kk = tid & 255, half = tid >> 8;
    for (int bc = bx; bc < 256; bc += G) {
      const size_t row0 = (size_t)bc * 64;
      {
          const int mt = wave & 3, khalf = wave >> 2, g4 = lane >> 4, l15 = lane & 15;
          f32x4 acc = {0.f, 0.f, 0.f, 0.f};
          const bf16_t* ap = HN + (row0 + 16 * mt + l15) * DM + 512 * khalf + 8 * g4;
          const bf16_t* bp = WRT + (size_t)l15 * DM + 512 * khalf + 8 * g4;
#pragma unroll
          for (int ks = 0; ks < 16; ++ks) acc = MFMA16(*(const bf16x8*)(ap + 32 * ks), *(const bf16x8*)(bp + 32 * ks), acc);
#pragma unroll
          for (int r = 0; r < 4; ++r) rpart[(khalf * 64 + 16 * mt + 4 * g4 + r) * 16 + l15] = acc[r];
          __syncthreads();
          for (int i = tid; i < 1024; i += NTHREADS) { const int t = i >> 4; sR[i] = (rpart[i] + rpart[1024 + i]) * rsqrtf(rsq[row0 + t] * (1.f / DM) + EPS); }
      }
      for (int h = 0; h < 4; ++h) {
        const int item = bc * 4 + h;
        float wa[16];
#pragma unroll
        for (int j = 0; j < 16; ++j) wa[j] = w_alpha[j * 1024 + h * 256 + kk];
        const float ba = b_alpha[h * 256 + kk];
        u32x4 tq[4], tk[4];
        const int prow = tid >> 5, pcc = tid & 31;
#pragma unroll
        for (int j = 0; j < 4; ++j) { const bf16_t* src = P + (row0 + prow + 16 * j) * NP + h * 256 + pcc * 8; tq[j] = *(const u32x4*)src; tk[j] = *(const u32x4*)(src + 1024); }
        __syncthreads();
        float cum[32]; float run = 0.f;
#pragma unroll
        for (int tt = 0; tt < 32; ++tt) {
            const int t = half * 32 + tt;
            float x = ba;
#pragma unroll
            for (int j = 0; j < 16; ++j) x += sR[t * 16 + j] * wa[j];
            run += logsigmoidf_(x) * (1.f / 16.f);
            cum[tt] = run;
        }
        tot[half * 256 + kk] = run;
#pragma unroll
        for (int j = 0; j < 4; ++j) { *(LAS u32x4*)(Qs + (prow + 16 * j) * GL_LDQ + pcc * 8) = tq[j]; *(LAS u32x4*)(Ks + (prow + 16 * j) * GL_LDQ + pcc * 8) = tk[j]; }
        __syncthreads();
        const float off = half ? tot[kk] : 0.f;
        const float gsum = tot[kk] + tot[256 + kk];
#pragma unroll
        for (int tt = 0; tt < 32; ++tt) {
            const int t = half * 32 + tt;
            const float c = cum[tt] + off;
            const float qv = bf2f(Qs[t * GL_LDQ + kk]), kv = bf2f(Ks[t * GL_LDQ + kk]);
            Qs[t * GL_LDQ + kk] = f2bf(qv * __expf(c) * (1.f / 16.f));
            Ks[t * GL_LDQ + kk] = f2bf(kv * __expf(-c));
            Ke[t * GL_LDQ + kk] = f2bf(kv * __expf(gsum - c));
        }
        if (half == 0) EG[(size_t)item * 256 + kk] = __expf(gsum);
        __syncthreads();
#pragma unroll
        for (int j = 0; j < 4; ++j) { bf16_t* dst = P + (row0 + prow + 16 * j) * NP + h * 256 + pcc * 8;
            *(u32x4*)dst = *(const LAS u32x4*)(Qs + (prow + 16 * j) * GL_LDQ + pcc * 8); *(u32x4*)(dst + 1024) = *(const LAS u32x4*)(Ke + (prow + 16 * j) * GL_LDQ + pcc * 8); }
#pragma unroll
        for (int j = 0; j < 2; ++j) {
            const int mt = wave >> 1, nt = 2 * (wave & 1) + j;
            f32x4 acc = {0.f, 0.f, 0.f, 0.f};
#pragma unroll
            for (int ks = 0; ks < 8; ++ks) acc = MFMA16(frag_rm(Qs, GL_LDQ, 16 * mt, 32 * ks, lane), frag_rm(Ks, GL_LDQ, 16 * nt, 32 * ks, lane), acc);
            const int sc = 16 * nt + (lane & 15);
#pragma unroll
            for (int r = 0; r < 4; ++r) { const int t = 16 * mt + 4 * (lane >> 4) + r; ATT[(size_t)item * 4096 + t * 64 + sc] = f2bf(sc <= t ? acc[r] : 0.f); }
        }
        __syncthreads();
      }
    }
}

__device__ __forceinline__ void gla_scan(bf16_t* P, const bf16_t* ATT, const float* EG, const float* head_g, float* SSQ, LAS unsigned char* lds, int bx, int wv) {
    int tid_ = wv * 64 + lane_id(); asm volatile("" : "+v"(tid_));
    const int tid = tid_, lane = tid & 63, wave = __builtin_amdgcn_readfirstlane(tid >> 6), kg = wave >> 2, vq = wave & 3, g4 = lane >> 4, l15 = lane & 15;
    const int bh = 4 * (bx & 7) + (bx >> 6), vs = (bx >> 3) & 7, b = bh >> 2, h = bh & 3;
    LAS bf16_t* Qt = (LAS bf16_t*)lds;
    LAS bf16_t* Ke = Qt + 64 * GL_LDQ;
    LAS bf16_t* At = Ke + 64 * GL_LDQ;
    LAS bf16_t* Vs = At + 64 * GL_LDA;
    LAS float* eg = (LAS float*)(Vs + 64 * GL_LDA);
    LAS float* part = eg + 256;
    LAS bf16_t* Zs = (LAS bf16_t*)(part + 4096);
    LAS float* ssqp = (LAS float*)(Zs + 64 * GL_LDA);
    const float hg = head_g[h * 512 + vs * 64 + 16 * vq + l15];
    f32x4 S[8];
#pragma unroll
    for (int i = 0; i < 8; ++i) S[i] = (f32x4){0.f, 0.f, 0.f, 0.f};
    u32x4 pq[4], pk[4], pa, pv, pz; f32x4 pe = {0.f, 0.f, 0.f, 0.f};
    const int prow = tid >> 5, pcc = tid & 31;
    const int arow = tid >> 3, acc8 = tid & 7;
#define GL_LOAD(c) do { const size_t rowg = (size_t)b * SEQ + (size_t)(c) * 64; const size_t item = ((size_t)b * 32 + (c)) * 4 + h; \
        _Pragma("unroll") for (int j = 0; j < 4; ++j) { const bf16_t* src = P + (rowg + prow + 16 * j) * NP + h * 256 + pcc * 8; pq[j] = *(const u32x4*)src; pk[j] = *(const u32x4*)(src + 1024); } \
        pa = *(const u32x4*)(ATT + item * 4096 + arow * 64 + acc8 * 8); \
        pv = *(const u32x4*)(P + (rowg + arow) * NP + 2048 + h * 512 + vs * 64 + acc8 * 8); \
        pz = *(const u32x4*)(P + (rowg + arow) * NP + 4096 + h * 512 + vs * 64 + acc8 * 8); \
        if (tid < 64) pe = *(const f32x4*)(EG + item * 256 + tid * 4); } while (0)
    GL_LOAD(0);
    for (int c = 0; c < 32; ++c) {
#pragma unroll
        for (int j = 0; j < 4; ++j) { *(LAS u32x4*)(Qt + (prow + 16 * j) * GL_LDQ + pcc * 8) = pq[j]; *(LAS u32x4*)(Ke + (prow + 16 * j) * GL_LDQ + pcc * 8) = pk[j]; }
        *(LAS u32x4*)(At + arow * GL_LDA + acc8 * 8) = pa;
        *(LAS u32x4*)(Vs + arow * GL_LDA + acc8 * 8) = pv;
        *(LAS u32x4*)(Zs + arow * GL_LDA + acc8 * 8) = pz;
        if (tid < 64) *(LAS f32x4*)(eg + tid * 4) = pe;
        __syncthreads();
        if (c + 1 < 32) GL_LOAD(c + 1);
        f32x4 o[4];
#pragma unroll
        for (int mt = 0; mt < 4; ++mt) o[mt] = (f32x4){0.f, 0.f, 0.f, 0.f};
#pragma unroll
        for (int ks = 0; ks < 4; ++ks) {
            u32x4 sw; sw.x = pk2(S[2 * ks][0], S[2 * ks][1]); sw.y = pk2(S[2 * ks][2], S[2 * ks][3]); sw.z = pk2(S[2 * ks + 1][0], S[2 * ks + 1][1]); sw.w = pk2(S[2 * ks + 1][2], S[2 * ks + 1][3]);
            const bf16x8 sb = __builtin_bit_cast(bf16x8, sw);
#pragma unroll
            for (int mt = 0; mt < 4; ++mt) {
                const LAS bf16_t* ap = Qt + (16 * mt + l15) * GL_LDQ + 128 * kg + 32 * ks + 4 * g4;
                const s16x4 lo = *(const LAS s16x4*)ap, hi = *(const LAS s16x4*)(ap + 16);
                o[mt] = MFMA16(cat8(lo, hi), sb, o[mt]);
            }
        }
        const bf16x8 bv0 = frag_tr(Vs, GL_LDA, 0, 16 * vq, lane), bv1 = frag_tr(Vs, GL_LDA, 32, 16 * vq, lane);
        const bf16x8 bvm = kg ? bv1 : bv0;
#pragma unroll
        for (int mt = 0; mt < 4; ++mt) o[mt] = MFMA16(frag_rm(At, GL_LDA, 16 * mt, 32 * kg, lane), bvm, o[mt]);
#pragma unroll
        for (int mh = 0; mh < 2; ++mh) {
            const int mt = kg ? mh : (2 + mh);
#pragma unroll
            for (int r = 0; r < 4; ++r) part[(vq * 64 + 16 * mt + 4 * g4 + r) * 16 + l15] = (mt == 0) ? o[0][r] : (mt == 1) ? o[1][r] : (mt == 2) ? o[2][r] : o[3][r];
        }
        __syncthreads();
        {
            const size_t rowg = (size_t)b * SEQ + (size_t)c * 64;
#pragma unroll
            for (int mh = 0; mh < 2; ++mh) {
                const int mt = kg ? (2 + mh) : mh;
#pragma unroll
                for (int r = 0; r < 4; ++r) {
                    const int t = 16 * mt + 4 * g4 + r;
                    const float own = (mt == 0) ? o[0][r] : (mt == 1) ? o[1][r] : (mt == 2) ? o[2][r] : o[3][r];
                    const float val = own + part[(vq * 64 + t) * 16 + l15];
                    const float zz = bf2f(Zs[t * GL_LDA + 16 * vq + l15]);
                    P[(rowg + t) * NP + 4096 + h * 512 + vs * 64 + 16 * vq + l15] = f2bf(val * hg * siluf_(zz));
                    const float q2 = red16(val * val);
                    if (l15 == 0) ssqp[vq * 64 + t] = q2;
                }
            }
        }
#pragma unroll
        for (int i = 0; i < 8; ++i) {
            const int k0 = 128 * kg + 16 * i;
            const f32x4 e4 = *(const LAS f32x4*)(eg + k0 + 4 * g4);
            S[i] = S[i] * e4;
            S[i] = MFMA16(frag_tr(Ke, GL_LDQ, 0, k0, lane), bv0, S[i]);
            S[i] = MFMA16(frag_tr(Ke, GL_LDQ, 32, k0, lane), bv1, S[i]);
        }
        __syncthreads();
        if (tid < 64) SSQ[(((size_t)b * SEQ + (size_t)c * 64 + tid) * 4 + h) * 8 + vs] = (ssqp[tid] + ssqp[64 + tid]) + (ssqp[128 + tid] + ssqp[192 + tid]);
    }
#undef GL_LOAD
}

__device__ __forceinline__ void headnorm1(bf16_t* P, const float* head_g, int gw, int ngw, int lane) {
    for (int item = gw; item < M_ * 4; item += ngw) {
        const int row = item >> 2, h = item & 3;
        bf16_t* pr = P + (size_t)row * NP;
        const u32x4 ov = *(const u32x4*)(pr + 2048 + h * 512 + lane * 8);
        const u32x4 zv = *(const u32x4*)(pr + 4096 + h * 512 + lane * 8);
        const unsigned ow[4] = {ov.x, ov.y, ov.z, ov.w}, zw[4] = {zv.x, zv.y, zv.z, zv.w};
        float val[8]; float ss = 0.f;
#pragma unroll
        for (int e = 0; e < 4; ++e) { val[2 * e] = bflo(ow[e]); val[2 * e + 1] = bfhi(ow[e]); ss += val[2 * e] * val[2 * e] + val[2 * e + 1] * val[2 * e + 1]; }
        ss = wave_sum(ss);
        const float inv = rsqrtf(ss * (1.f / 512.f) + EPS);
        const f32x4 g0 = *(const f32x4*)(head_g + h * 512 + lane * 8), g1 = *(const f32x4*)(head_g + h * 512 + lane * 8 + 4);
        float o[8];
#pragma unroll
        for (int e = 0; e < 4; ++e) {
            const float ga = (e < 2) ? g0[2 * e] : g1[2 * e - 4], gb = (e < 2) ? g0[2 * e + 1] : g1[2 * e - 3];
            o[2 * e] = val[2 * e] * inv * ga * siluf_(bflo(zw[e]));
            o[2 * e + 1] = val[2 * e + 1] * inv * gb * siluf_(bfhi(zw[e]));
        }
        u32x4 w; w.x = pk2(o[0], o[1]); w.y = pk2(o[2], o[3]); w.z = pk2(o[4], o[5]); w.w = pk2(o[6], o[7]);
        *(u32x4*)(pr + 4096 + h * 512 + lane * 8) = w;
    }
}

__device__ __forceinline__ void final_norm(float* X, const float* g, int gw, int ngw, int lane) {
    for (int row = gw; row < M_; row += ngw) {
        float* xr = X + (size_t)row * DM;
        f32x4 v[4]; float ss = 0.f;
#pragma unroll
        for (int j = 0; j < 4; ++j) { v[j] = *(const f32x4*)(xr + j * 256 + lane * 4); ss += v[j][0] * v[j][0] + v[j][1] * v[j][1] + v[j][2] * v[j][2] + v[j][3] * v[j][3]; }
        ss = wave_sum(ss);
        const float inv = rsqrtf(ss * (1.f / DM) + EPS);
#pragma unroll
        for (int j = 0; j < 4; ++j) { const f32x4 gg = *(const f32x4*)(g + j * 256 + lane * 4); *(f32x4*)(xr + j * 256 + lane * 4) = v[j] * inv * gg; }
    }
}

__global__ void __launch_bounds__(NTHREADS, 2) mega_fwd(Args a) {
    extern __shared__ __attribute__((aligned(16))) unsigned char lds_raw[];
    LAS unsigned char* lds = (LAS unsigned char*)lds_raw;
    volatile LAS unsigned* MISC = (volatile LAS unsigned*)(lds + RING_BYTES);
    const int wave = __builtin_amdgcn_readfirstlane(threadIdx.x >> 6);
    if (wave == 0) MISC[lane_id()] = 0u;
    __syncthreads();
    const XcdBarrier gbar = xcd_barrier_post((unsigned*)a.ws, MISC + 8, wave);
#define FRESH_LANE ({ int l_ = lane_id(); asm volatile("" : "+v"(l_)); l_; })
    const int G = gridDim.x, bx = blockIdx.x;
    const int gw = bx * NWAVES + wave, ngw = G * NWAVES;
    unsigned char* ws = a.ws;
    bf16_t* WIN = (bf16_t*)(ws + WS_WIN); bf16_t* WGLU = (bf16_t*)(ws + WS_WGLU); bf16_t* WOUT0 = (bf16_t*)(ws + WS_WOUT0); bf16_t* WOUT1 = (bf16_t*)(ws + WS_WOUT1);
    bf16_t* HN = (bf16_t*)(ws + WS_HN); bf16_t* P = (bf16_t*)(ws + WS_P);
    bf16_t* ATT = (bf16_t*)(ws + WS_WIN); float* EGB = (float*)(ws + WS_WIN + 8 * MiB);
    bf16_t* WRT = (bf16_t*)(ws + WS_R);
    float* SSQ = (float*)(ws + 250 * MiB);
    float* GIF = (float*)(ws + WS_GIF); float* R = (float*)(ws + WS_R); float* RSQ0 = (float*)(ws + WS_RSQ0); float* RSQ1 = (float*)(ws + WS_RSQ1);
    const float* x = a.in[0]; const float* norm_g = a.in[1]; float* out = a.out;
    float* XE = (float*)((unsigned char*)a.out + SCR_XE);
    float* CSEG = (float*)((unsigned char*)a.out + SCR_CSEG); float* NSEGN = (float*)((unsigned char*)a.out + SCR_NSEG); float* SCAL = (float*)((unsigned char*)a.out + SCR_SCAL);
    LAS float* scr = (LAS float*)(lds + wave * 16384);

    convert_weight(a.in[3], 6152, 1024, 6144, norm_g, 1, WIN, scr, gw, ngw, FRESH_LANE);
    convert_weight(a.in[17], 1024, 1024, 1024, nullptr, 0, WGLU, scr, gw, ngw, FRESH_LANE);
    convert_weight(a.in[19], 1024, 2048, 1024, nullptr, 0, WOUT0, scr, gw, ngw, FRESH_LANE);
    convert_weight(a.in[24], 1024, 2048, 1024, nullptr, 0, WOUT1, scr, gw, ngw, FRESH_LANE);
    { const int l0 = FRESH_LANE; for (int i = gw * 64 + l0; i < M_; i += ngw * 64) RSQ1[i] = 0.f;
      const float* wi1 = a.in[20]; const float* g1 = norm_g + 1024;
      for (int i = gw * 64 + l0; i < 16 * 1024; i += ngw * 64) { const int j = i >> 10, k = i & 1023; WRT[i] = f2bf(g1[k] * wi1[(size_t)k * 6160 + 6144 + j]); } }
    __syncthreads();
    rows_prep<8>(x, norm_g, a.in[3], 6152, 3072, a.in[6], a.in[7], HN, RSQ0, GIF, (LAS float*)lds, gw, ngw, FRESH_LANE, wave);
    xcd_barrier(gbar);
    { pg8::Gemm g{HN, DM, WIN, M_, 6144, 1024}; pg8::StaticOrder S; S.init(M_, 6144, G, bx); pg8::EpiProj E{P, RSQ0}; pg8::gemm_phase<pg8::EpiProj>(lds, g, S, E, wave); }
    xcd_barrier(gbar);
    mlstm_passA(P, GIF, a.in[4], a.in[5], CSEG, NSEGN, SCAL, lds, bx, wave);
    for (int it = gw; it < 2048; it += ngw) s5_passA(P, a.in[9], a.in[10], a.in[11], a.in[12], a.in[13], XE, it, FRESH_LANE);
    convert_weight(a.in[20], 6160, 1024, 6144, norm_g + 1024, 0, WIN, scr, gw, ngw, FRESH_LANE);
    xcd_barrier(gbar);
    mlstm_passB(P, GIF, a.in[4], a.in[5], a.in[8], CSEG, NSEGN, SCAL, lds, bx, ML_NSEG, wave);
    { LAS bf16_t* img = (LAS bf16_t*)(lds + wave * S5_IMG_BYTES);
      for (int it = gw; it < 2048; it += ngw) s5_passB(P, a.in[9], a.in[10], a.in[11], a.in[12], a.in[13], a.in[14], a.in[15], a.in[16], XE, img, it, FRESH_LANE); }
    xcd_barrier(gbar);
    { pg8::Gemm g{P + 2048, NP, WGLU, M_, 1024, 1024}; pg8::StaticOrder S; S.init(M_, 1024, G, bx); pg8::EpiGlu E{P, a.in[18]}; pg8::gemm_phase<pg8::EpiGlu>(lds, g, S, E, wave); }
    xcd_barrier(gbar);
    { pg8::Gemm g{P + 3072, NP, WOUT0, M_, 1024, 2048}; pg8::StaticOrder S; S.init(M_, 1024, G, bx); pg8::EpiResHN E{x, out, HN, RSQ1}; pg8::gemm_phase<pg8::EpiResHN>(lds, g, S, E, wave); }
    xcd_barrier(gbar);
    { pg8::Gemm g{HN, DM, WIN, M_, 6144, 1024}; pg8::StaticOrder S; S.init(M_, 6144, G, bx); pg8::EpiProj E{P, RSQ1}; pg8::gemm_phase<pg8::EpiProj>(lds, g, S, E, wave); }
    xcd_barrier(gbar);
    gla_prep(P, HN, WRT, RSQ1, a.in[21], a.in[22], ATT, EGB, lds, bx, G, wave);
    xcd_barrier(gbar);
    gla_scan(P, ATT, EGB, a.in[23], SSQ, lds, bx, wave);
    xcd_barrier(gbar);
    { pg8::Gemm g{P + 4096, NP, WOUT1, M_, 1024, 2048}; pg8::StaticOrder S; S.init(M_, 1024, G, bx); pg8::EpiResH E{out, out, SSQ}; pg8::gemm_phase<pg8::EpiResH>(lds, g, S, E, wave); }
    xcd_barrier(gbar);
    final_norm(out, a.in[2], gw, ngw, FRESH_LANE);
}

extern "C" void kernel_launch(void* const* d_in, const int* in_sizes, int n_in, void* d_out, int out_size, void* d_ws, size_t ws_size, hipStream_t stream) {
    static int grid = 0;
    if (grid == 0) {
        int dev = 0, cus = 0, per_cu = 0;
        hipGetDevice(&dev);
        hipDeviceGetAttribute(&cus, hipDeviceAttributeMultiprocessorCount, dev);
        hipFuncSetAttribute((const void*)mega_fwd, hipFuncAttributeMaxDynamicSharedMemorySize, LDS_BYTES);
        hipOccupancyMaxActiveBlocksPerMultiprocessor(&per_cu, (const void*)mega_fwd, NTHREADS, LDS_BYTES);
        if (per_cu < 1) { fprintf(stderr, "kernel_launch: occupancy query reports %d blocks/CU\n", per_cu); per_cu = 1; }
        grid = cus;
        (void)hipGetLastError();
    }
    (void)hipMemsetAsync(d_ws, 0, 16384, stream);
    Args a{};
    for (int i = 0; i < 25; ++i) a.in[i] = (const float*)d_in[i];
    a.out = (float*)d_out; a.ws = (unsigned char*)d_ws;
    void* args[] = {&a};
    hipError_t e = hipLaunchCooperativeKernel((const void*)mega_fwd, dim3(grid), dim3(NTHREADS), args, LDS_BYTES, stream);
    if (e != hipSuccess) fprintf(stderr, "cooperative launch failed: %s (grid %d)\n", hipGetErrorString(e), grid);
}
```
